# Optimizing an MI355X kernel written in HIP

```python
import jax, jax.numpy as jnp
from jax import lax
import numpy as np

D_MODEL = 1024
BATCH = 8
SEQ = 4096
DEPTH = 4

N_A_LAYERS = DEPTH // 2
N_B_LAYERS = DEPTH - N_A_LAYERS
HEAD_DIM = 64
MIX_WIDTH = D_MODEL
MAIN_WIDTH = 3 * MIX_WIDTH // 4
MEM_WIDTH = MIX_WIDTH // 4
CONV_CH = MAIN_WIDTH
CONV_K = 3
N_FOX_HEADS = MAIN_WIDTH // HEAD_DIM
FOX_WIDTH = N_FOX_HEADS * HEAD_DIM
N_MEM_HEADS = MEM_WIDTH // HEAD_DIM
N_MEM = 256
Q_BLOCK = 128
PEER_HEADS = 8
PEER_NKEYS = 128
PEER_N = PEER_NKEYS * PEER_NKEYS
PEER_DKEY = 256
PEER_HALF = PEER_DKEY // 2
PEER_TOPK = 16
PEER_CHUNK = 128
EPS = 1e-6

kernel_name = "yoco_shortconv_fox_memxattn_peer"


def rmsnorm(x, g):
    xf = x.astype(jnp.float32)
    y = xf * lax.rsqrt(jnp.mean(xf * xf, axis=-1, keepdims=True) + EPS)
    return (y * g.astype(jnp.float32)).astype(x.dtype)


def causal_dwconv(u, w):
    c = u.shape[-1]
    return lax.conv_general_dilated(
        u, w[:, None, :].astype(u.dtype), window_strides=(1,),
        padding=[(CONV_K - 1, 0)], dimension_numbers=("NWC", "WIO", "NWC"),
        feature_group_count=c)


def mem_attention(q, mk, mv):
    scale = HEAD_DIM ** -0.5
    logits = jnp.einsum("bshd,bmhd->bhsm", q, mk).astype(jnp.float32) * scale
    p = jax.nn.softmax(logits, axis=-1).astype(mv.dtype)
    return jnp.einsum("bhsm,bmhd->bshd", p, mv)


def fox_attention(q, k, v, logf):
    bsz, s_len, h, dh = q.shape
    scale = dh ** -0.5
    c = jnp.cumsum(logf, axis=1).transpose(0, 2, 1)
    nb = s_len // Q_BLOCK
    qb = q.reshape(bsz, nb, Q_BLOCK, h, dh).transpose(1, 0, 2, 3, 4)
    cb = c.reshape(bsz, h, nb, Q_BLOCK).transpose(2, 0, 1, 3)
    kpos = jnp.arange(s_len)

    def block(args):
        i, qi, ci = args
        logits = jnp.einsum("bqhd,bkhd->bhqk", qi, k).astype(jnp.float32) * scale
        logits = logits + ci[..., :, None] - c[:, :, None, :]
        qpos = i * Q_BLOCK + jnp.arange(Q_BLOCK)
        mask = kpos[None, :] <= qpos[:, None]
        logits = jnp.where(mask[None, None], logits, -jnp.inf)
        p = jax.nn.softmax(logits, axis=-1).astype(v.dtype)
        return jnp.einsum("bhqk,bkhd->bqhd", p, v)

    out = lax.map(block, (jnp.arange(nb), qb, cb))
    return out.transpose(1, 0, 2, 3, 4).reshape(bsz, s_len, h, dh)


def peer(xn, w_q, sub_keys, u_tab, v_tab):
    bsz, s_len, d = xn.shape
    t = bsz * s_len
    xt = xn.reshape(t, d)
    q = (xt @ w_q).reshape(t, PEER_HEADS, 2, PEER_HALF)
    s = jnp.einsum("thpd,hpnd->thpn", q, sub_keys).astype(jnp.float32)
    s1, i1 = lax.top_k(s[:, :, 0], PEER_TOPK)
    s2, i2 = lax.top_k(s[:, :, 1], PEER_TOPK)
    cand = (s1[..., :, None] + s2[..., None, :]).reshape(t, PEER_HEADS, PEER_TOPK * PEER_TOPK)
    cand_idx = (i1[..., :, None] * PEER_NKEYS + i2[..., None, :]).reshape(t, PEER_HEADS, PEER_TOPK * PEER_TOPK)
    top_s, pos = lax.top_k(cand, PEER_TOPK)
    idx = jnp.take_along_axis(cand_idx, pos, axis=-1)
    g = jax.nn.softmax(top_s, axis=-1).astype(xn.dtype)
    nc = t // PEER_CHUNK

    def chunk(args):
        xc, ic, gc = args
        u = jnp.take(u_tab, ic, axis=0)
        a = jnp.einsum("cd,chkd->chk", xc, u)
        w = gc * jax.nn.gelu(a, approximate=False)
        vv = jnp.take(v_tab, ic, axis=0)
        return jnp.einsum("chk,chkd->cd", w, vv)

    out = lax.map(chunk, (xt.reshape(nc, PEER_CHUNK, d),
                          idx.reshape(nc, PEER_CHUNK, PEER_HEADS, PEER_TOPK),
                          g.reshape(nc, PEER_CHUNK, PEER_HEADS, PEER_TOPK)))
    return out.reshape(bsz, s_len, d)


def setup_inputs(seed: int = 0) -> dict:
    key = jax.random.key(seed)
    ks = jax.random.split(key, 20)
    f32 = jnp.float32
    d = D_MODEL

    def nrm(k, shape, scale):
        return jax.random.normal(k, shape, f32) * scale

    def gain(k, shape):
        return 1.0 + 0.02 * jax.random.normal(k, shape, f32)

    return {
        "x": nrm(ks[0], (BATCH, SEQ, d), 1.0),
        "mem": nrm(ks[1], (BATCH, N_MEM, d), 1.0),
        "g_mix": gain(ks[2], (DEPTH, d)),
        "w_in_a": nrm(ks[3], (N_A_LAYERS, d, 3 * CONV_CH + MEM_WIDTH), d ** -0.5),
        "conv_w": nrm(ks[4], (N_A_LAYERS, CONV_K, CONV_CH), CONV_K ** -0.5),
        "w_in_b": nrm(ks[5], (N_B_LAYERS, d, FOX_WIDTH + MEM_WIDTH), d ** -0.5),
        "w_out": nrm(ks[6], (DEPTH, MIX_WIDTH, d), MIX_WIDTH ** -0.5),
        "g_mem": gain(ks[7], (DEPTH, d)),
        "w_mem_kv": nrm(ks[8], (DEPTH, d, 2 * MEM_WIDTH), d ** -0.5),
        "g_kv": gain(ks[9], (d,)),
        "w_kv": nrm(ks[10], (d, 2 * FOX_WIDTH + N_FOX_HEADS), d ** -0.5),
        "b_f": 2.0 + 0.1 * jax.random.normal(ks[11], (N_FOX_HEADS,), f32),
        "g_ffn": gain(ks[12], (DEPTH, d)),
        "peer_wq": nrm(ks[13], (DEPTH, d, PEER_HEADS * PEER_DKEY), d ** -0.5),
        "peer_keys": nrm(ks[14], (DEPTH, PEER_HEADS, 2, PEER_NKEYS, PEER_HALF), PEER_HALF ** -0.5),
        "peer_u": nrm(ks[15], (DEPTH, PEER_N, d), d ** -0.5),
        "peer_v": nrm(ks[16], (DEPTH, PEER_N, d), PEER_TOPK ** -0.5),
        "g_final": gain(ks[17], (d,)),
    }


def reference(x, mem, g_mix, w_in_a, conv_w, w_in_b, w_out, g_mem, w_mem_kv,
              g_kv, w_kv, b_f, g_ffn, peer_wq, peer_keys, peer_u, peer_v, g_final):
    bsz, s_len, _ = x.shape
    k_sh = v_sh = logf_sh = None
    for layer in range(DEPTH):
        if layer == N_A_LAYERS:
            hs = rmsnorm(x, g_kv)
            zkv = hs @ w_kv
            k_sh = zkv[..., :FOX_WIDTH].reshape(bsz, s_len, N_FOX_HEADS, HEAD_DIM)
            v_sh = zkv[..., FOX_WIDTH:2 * FOX_WIDTH].reshape(bsz, s_len, N_FOX_HEADS, HEAD_DIM)
            zf = zkv[..., 2 * FOX_WIDTH:].astype(jnp.float32) + b_f.astype(jnp.float32)
            logf_sh = jax.nn.log_sigmoid(zf)

        h = rmsnorm(x, g_mix[layer])
        mn = rmsnorm(mem, g_mem[layer])
        mkv = (mn @ w_mem_kv[layer]).reshape(bsz, N_MEM, 2, N_MEM_HEADS, HEAD_DIM)
        mk, mv = mkv[:, :, 0], mkv[:, :, 1]

        if layer < N_A_LAYERS:
            z = h @ w_in_a[layer]
            u = z[..., :CONV_CH]
            c_gate = z[..., CONV_CH:2 * CONV_CH]
            b_gate = z[..., 2 * CONV_CH:3 * CONV_CH]
            qm = z[..., 3 * CONV_CH:]
            y_main = b_gate * causal_dwconv(c_gate * u, conv_w[layer])
        else:
            z = h @ w_in_b[layer - N_A_LAYERS]
            qf = z[..., :FOX_WIDTH].reshape(bsz, s_len, N_FOX_HEADS, HEAD_DIM)
            qm = z[..., FOX_WIDTH:]
            y_main = fox_attention(qf, k_sh, v_sh, logf_sh).reshape(bsz, s_len, FOX_WIDTH)

        y_mem = mem_attention(qm.reshape(bsz, s_len, N_MEM_HEADS, HEAD_DIM), mk, mv)
        y_mem = y_mem.reshape(bsz, s_len, MEM_WIDTH)
        x = x + jnp.concatenate([y_main, y_mem], axis=-1) @ w_out[layer]
        x = x + peer(rmsnorm(x, g_ffn[layer]), peer_wq[layer], peer_keys[layer],
                     peer_u[layer], peer_v[layer])
    return rmsnorm(x, g_final)
```

```cpp
#include <hip/hip_runtime.h>
#include <cstdio>
#include <cstdint>

typedef unsigned short bf16;
typedef short bf16x8 __attribute__((ext_vector_type(8)));
typedef float f32x16 __attribute__((ext_vector_type(16)));
typedef float f32x4 __attribute__((ext_vector_type(4)));
typedef unsigned u32x4 __attribute__((ext_vector_type(4)));
typedef unsigned u32x2 __attribute__((ext_vector_type(2)));

constexpr int BATCH = 8, SEQ = 4096, T = BATCH * SEQ, D = 1024;
constexpr int NA = 2560, NB = 1024, NKV = 1548, NKVP = 1792, NPQ = 2048, NMEM = 256;
constexpr int FOXH = 12, MEMH = 4, PH = 8, PK = 16, NEXP = 16384;
constexpr float EPS = 1e-6f;
constexpr float C2 = 0.125f * 1.4426950408889634f;
constexpr float LOG2E = 1.4426950408889634f;

constexpr size_t MiB = 1u << 20;
constexpr size_t WS_CTL = 0;
constexpr size_t WS_WINA = 2 * MiB;
constexpr size_t WS_WINB = 12 * MiB;
constexpr size_t WS_WOUT = 16 * MiB;
constexpr size_t WS_WMKV = 24 * MiB;
constexpr size_t WS_WKV = 28 * MiB;
constexpr size_t WS_WPQ = 32 * MiB;
constexpr size_t WS_PKEYS = 48 * MiB;
constexpr size_t WS_MN = 50 * MiB;
constexpr size_t WS_MKV = 66 * MiB;
constexpr size_t WS_LOGF = 74 * MiB;
constexpr size_t WS_C2 = 76 * MiB;
constexpr size_t WS_XN = 80 * MiB;
constexpr size_t WS_XKV = 144 * MiB;
constexpr size_t WS_Z = 208 * MiB;
constexpr size_t WS_PQ = 368 * MiB;
constexpr size_t WS_KV = 496 * MiB;
constexpr size_t WS_YCAT = 592 * MiB;
constexpr size_t WS_IDX = 656 * MiB;
constexpr size_t WS_GATE = 672 * MiB;
constexpr size_t WS_U = 688 * MiB;
constexpr size_t WS_V = 816 * MiB;
constexpr size_t WS_END = 944 * MiB;

__device__ __forceinline__ unsigned f2bf(float f) { unsigned u = __builtin_bit_cast(unsigned, f); return (u + 0x7fffu + ((u >> 16) & 1u)) >> 16; }
__device__ __forceinline__ unsigned pk2(float lo, float hi) { return f2bf(lo) | (f2bf(hi) << 16); }
__device__ __forceinline__ float bflo(unsigned u) { return __uint_as_float(u << 16); }
__device__ __forceinline__ float bfhi(unsigned u) { return __uint_as_float(u & 0xffff0000u); }
__device__ __forceinline__ int crow(int r, int hi) { return (r & 3) + 8 * (r >> 2) + 4 * hi; }
__device__ __forceinline__ float wave_sum(float v) {
#pragma unroll
    for (int o = 1; o < 64; o <<= 1) v += __shfl_xor(v, o);
    return v;
}

__global__ void __launch_bounds__(256) k_transpose(const float* __restrict__ W, int K, int N, bf16* __restrict__ WT, int Npad) {
    __shared__ float tile[32][33];
    const int tx = threadIdx.x & 31, ty = threadIdx.x >> 5;
    const int n0 = blockIdx.x * 32, k0 = blockIdx.y * 32;
#pragma unroll
    for (int i = 0; i < 4; ++i) { const int k = k0 + ty + 8 * i, n = n0 + tx; tile[ty + 8 * i][tx] = (n < N) ? W[(size_t)k * N + n] : 0.f; }
    __syncthreads();
#pragma unroll
    for (int i = 0; i < 4; ++i) { const int n = n0 + ty + 8 * i, k = k0 + tx; WT[(size_t)n * K + k] = (bf16)f2bf(tile[tx][ty + 8 * i]); }
}
__global__ void __launch_bounds__(256) k_cvt(const float* __restrict__ src, bf16* __restrict__ dst, size_t n8) {
    size_t i = (size_t)blockIdx.x * 256 + threadIdx.x; const size_t stride = (size_t)gridDim.x * 256;
    for (; i < n8; i += stride) {
        const f32x4 a = ((const f32x4*)src)[2 * i], b = ((const f32x4*)src)[2 * i + 1];
        u32x4 o; o.x = pk2(a.x, a.y); o.y = pk2(a.z, a.w); o.z = pk2(b.x, b.y); o.w = pk2(b.z, b.w);
        ((u32x4*)dst)[i] = o;
    }
}
__global__ void __launch_bounds__(256) k_rmsnorm(const float* x, const float* __restrict__ g1, bf16* o1, const float* __restrict__ g2, bf16* o2, float* of, int rows) {
    const int lane = threadIdx.x & 63; const int row = blockIdx.x * 4 + (threadIdx.x >> 6);
    if (row >= rows) return;
    const f32x4* xr = (const f32x4*)(x + (size_t)row * D) + lane;
    f32x4 v[4]; float s = 0.f;
#pragma unroll
    for (int j = 0; j < 4; ++j) { v[j] = xr[64 * j]; s += (v[j].x * v[j].x + v[j].y * v[j].y) + (v[j].z * v[j].z + v[j].w * v[j].w); }
    const float rstd = 1.0f / sqrtf(wave_sum(s) * (1.f / D) + EPS);
#pragma unroll
    for (int j = 0; j < 4; ++j) {
        const f32x4 g = ((const f32x4*)g1)[64 * j + lane]; const f32x4 y = v[j] * rstd * g;
        if (o1) { u32x2 w; w.x = pk2(y.x, y.y); w.y = pk2(y.z, y.w); ((u32x2*)(o1 + (size_t)row * D))[64 * j + lane] = w; }
        if (of) ((f32x4*)(of + (size_t)row * D))[64 * j + lane] = y;
        if (o2) { const f32x4 gg = ((const f32x4*)g2)[64 * j + lane]; const f32x4 y2 = v[j] * rstd * gg; u32x2 w; w.x = pk2(y2.x, y2.y); w.y = pk2(y2.z, y2.w); ((u32x2*)(o2 + (size_t)row * D))[64 * j + lane] = w; }
    }
}

struct GemmEpi { int mode; bf16* O; int ldc; int scale_from; float scale; const float* res; float* outf; const float* b_f; float* logf; };
__global__ void __launch_bounds__(256) k_gemm(const bf16* __restrict__ A, const bf16* __restrict__ Bt, int M, int N, int K, GemmEpi e) {
    const int tid = threadIdx.x, wave = tid >> 6, lane = tid & 63, r32 = lane & 31, hi = lane >> 5;
    const int m0 = blockIdx.y * 128 + (wave >> 1) * 64, n0 = blockIdx.x * 128 + (wave & 1) * 64;
    f32x16 acc[2][2];
#pragma unroll
    for (int i = 0; i < 2; ++i)
#pragma unroll
        for (int j = 0; j < 2; ++j)
#pragma unroll
            for (int r = 0; r < 16; ++r) acc[i][j][r] = 0.f;
    const bf16* ap0 = A + (size_t)(m0 + r32) * K + 8 * hi; const bf16* ap1 = ap0 + (size_t)32 * K;
    const bf16* bp0 = Bt + (size_t)(n0 + r32) * K + 8 * hi; const bf16* bp1 = bp0 + (size_t)32 * K;
#pragma unroll 4
    for (int k = 0; k < K; k += 16) {
        const bf16x8 a0 = *(const bf16x8*)(ap0 + k), a1 = *(const bf16x8*)(ap1 + k), b0 = *(const bf16x8*)(bp0 + k), b1 = *(const bf16x8*)(bp1 + k);
        acc[0][0] = __builtin_amdgcn_mfma_f32_32x32x16_bf16(a0, b0, acc[0][0], 0, 0, 0);
        acc[0][1] = __builtin_amdgcn_mfma_f32_32x32x16_bf16(a0, b1, acc[0][1], 0, 0, 0);
        acc[1][0] = __builtin_amdgcn_mfma_f32_32x32x16_bf16(a1, b0, acc[1][0], 0, 0, 0);
        acc[1][1] = __builtin_amdgcn_mfma_f32_32x32x16_bf16(a1, b1, acc[1][1], 0, 0, 0);
    }
#pragma unroll
    for (int i = 0; i < 2; ++i)
#pragma unroll
        for (int j = 0; j < 2; ++j)
#pragma unroll
            for (int r = 0; r < 16; ++r) {
                const int row = m0 + 32 * i + crow(r, hi), col = n0 + 32 * j + r32; const float v = acc[i][j][r];
                if (e.mode == 0) { const float sc = (col >= e.scale_from) ? e.scale : 1.f; e.O[(size_t)row * e.ldc + col] = (bf16)f2bf(v * sc); }
                else if (e.mode == 1) { e.outf[(size_t)row * e.ldc + col] = e.res[(size_t)row * e.ldc + col] + v; }
                else {
                    if (col < 1536) e.O[(size_t)row * 1536 + col] = (bf16)f2bf(v);
                    else if (col < NKV) { const int h = col - 1536; const float z = v + e.b_f[h]; const float ls = fminf(z, 0.f) - log1pf(expf(-fabsf(z)));
                        const int b = row / SEQ, s = row % SEQ; e.logf[((size_t)(b * FOXH + h)) * SEQ + s] = ls; }
                }
            }
}

__global__ void __launch_bounds__(256) k_conv(const bf16* __restrict__ Z, const float* __restrict__ cw, bf16* __restrict__ Y) {
    const int item = blockIdx.x * 256 + threadIdx.x; const int cg8 = item % 96, strip = item / 96;
    if (strip >= T / 16) return;
    const int t0 = strip * 16, c0 = cg8 * 8;
    float w0[8], w1[8], w2[8], p2[8], p1[8];
#pragma unroll
    for (int i = 0; i < 8; ++i) { w0[i] = cw[c0 + i]; w1[i] = cw[768 + c0 + i]; w2[i] = cw[1536 + c0 + i]; p2[i] = 0.f; p1[i] = 0.f; }
    auto prod = [&](int row, float* p) {
        const u32x4 u = *(const u32x4*)(Z + (size_t)row * NA + c0), c = *(const u32x4*)(Z + (size_t)row * NA + 768 + c0);
        p[0] = bflo(u.x) * bflo(c.x); p[1] = bfhi(u.x) * bfhi(c.x); p[2] = bflo(u.y) * bflo(c.y); p[3] = bfhi(u.y) * bfhi(c.y);
        p[4] = bflo(u.z) * bflo(c.z); p[5] = bfhi(u.z) * bfhi(c.z); p[6] = bflo(u.w) * bflo(c.w); p[7] = bfhi(u.w) * bfhi(c.w);
    };
    if ((t0 % SEQ) != 0) { prod(t0 - 2, p2); prod(t0 - 1, p1); }
#pragma unroll 4
    for (int i = 0; i < 16; ++i) {
        const int row = t0 + i; float p0[8]; prod(row, p0);
        const u32x4 bg = *(const u32x4*)(Z + (size_t)row * NA + 1536 + c0);
        float bb[8] = {bflo(bg.x), bfhi(bg.x), bflo(bg.y), bfhi(bg.y), bflo(bg.z), bfhi(bg.z), bflo(bg.w), bfhi(bg.w)};
        float y[8];
#pragma unroll
        for (int q = 0; q < 8; ++q) { y[q] = bb[q] * (w0[q] * p2[q] + w1[q] * p1[q] + w2[q] * p0[q]); p2[q] = p1[q]; p1[q] = p0[q]; }
        u32x4 o; o.x = pk2(y[0], y[1]); o.y = pk2(y[2], y[3]); o.z = pk2(y[4], y[5]); o.w = pk2(y[6], y[7]);
        *(u32x4*)(Y + (size_t)row * D + c0) = o;
    }
}

__global__ void __launch_bounds__(64) k_cumsum(const float* __restrict__ logf, float* __restrict__ c2) {
    const int bh = blockIdx.x, lane = threadIdx.x; const float* src = logf + (size_t)bh * SEQ + lane * 64; float* dst = c2 + (size_t)bh * SEQ + lane * 64;
    float s = 0.f;
    for (int i = 0; i < 64; ++i) s += src[i];
    float incl = s;
#pragma unroll
    for (int o = 1; o < 64; o <<= 1) { const float t = __shfl_up(incl, o); if (lane >= o) incl += t; }
    float run = incl - s;
    for (int i = 0; i < 64; ++i) { run += src[i]; dst[i] = run * LOG2E; }
}

__global__ void __launch_bounds__(256) k_attn_naive(const bf16* __restrict__ Q, int qpitch, int qcol0, const bf16* __restrict__ KV, int kvpitch, int kcol0, int vcol0, int kv_rows_per_batch,
                                                    bf16* __restrict__ O, int opitch, int ocol0, int H, int kv_len, int causal, const float* __restrict__ c2) {
    const int gid = blockIdx.x * 256 + threadIdx.x; const int q = gid % SEQ, h = (gid / SEQ) % H, b = gid / (SEQ * H);
    const size_t qrow = (size_t)b * SEQ + q;
    float qv[64], o[64];
    { const u32x4* qp = (const u32x4*)(Q + qrow * qpitch + qcol0 + h * 64);
#pragma unroll
      for (int i = 0; i < 8; ++i) { const u32x4 w = qp[i]; qv[8 * i] = bflo(w.x); qv[8 * i + 1] = bfhi(w.x); qv[8 * i + 2] = bflo(w.y); qv[8 * i + 3] = bfhi(w.y); qv[8 * i + 4] = bflo(w.z); qv[8 * i + 5] = bfhi(w.z); qv[8 * i + 6] = bflo(w.w); qv[8 * i + 7] = bfhi(w.w); } }
#pragma unroll
    for (int i = 0; i < 64; ++i) o[i] = 0.f;
    float m = -1e30f, l = 0.f;
    const int nk = causal ? q + 1 : kv_len;
    int nkmax = nk;
#pragma unroll
    for (int of = 1; of < 64; of <<= 1) nkmax = max(nkmax, __shfl_xor(nkmax, of));
    const bf16* kb = KV + (size_t)b * kv_rows_per_batch * kvpitch + kcol0 + h * 64;
    const bf16* vb = KV + (size_t)b * kv_rows_per_batch * kvpitch + vcol0 + h * 64;
    const float* cc = c2 ? c2 + (size_t)(b * H + h) * SEQ : nullptr;
    const float cq = cc ? cc[q] : 0.f;
    for (int s = 0; s < nkmax; ++s) {
        const u32x4* kp = (const u32x4*)(kb + (size_t)s * kvpitch);
        float dot = 0.f;
#pragma unroll
        for (int i = 0; i < 8; ++i) { const u32x4 w = kp[i];
            dot += qv[8 * i] * bflo(w.x) + qv[8 * i + 1] * bfhi(w.x) + qv[8 * i + 2] * bflo(w.y) + qv[8 * i + 3] * bfhi(w.y) + qv[8 * i + 4] * bflo(w.z) + qv[8 * i + 5] * bfhi(w.z) + qv[8 * i + 6] * bflo(w.w) + qv[8 * i + 7] * bfhi(w.w); }
        if (cc) dot += cq - cc[s];
        if (s < nk) {
            const float mn = fmaxf(m, dot); const float f = exp2f(m - mn), p = exp2f(dot - mn);
            l = l * f + p; m = mn;
            const u32x4* vp = (const u32x4*)(vb + (size_t)s * kvpitch);
#pragma unroll
            for (int i = 0; i < 8; ++i) { const u32x4 w = vp[i];
                o[8 * i] = o[8 * i] * f + p * bflo(w.x); o[8 * i + 1] = o[8 * i + 1] * f + p * bfhi(w.x); o[8 * i + 2] = o[8 * i + 2] * f + p * bflo(w.y); o[8 * i + 3] = o[8 * i + 3] * f + p * bfhi(w.y);
                o[8 * i + 4] = o[8 * i + 4] * f + p * bflo(w.z); o[8 * i + 5] = o[8 * i + 5] * f + p * bfhi(w.z); o[8 * i + 6] = o[8 * i + 6] * f + p * bflo(w.w); o[8 * i + 7] = o[8 * i + 7] * f + p * bfhi(w.w); }
        }
    }
    const float inv = 1.f / l;
    u32x4* op = (u32x4*)(O + qrow * opitch + ocol0 + h * 64);
#pragma unroll
    for (int i = 0; i < 8; ++i) { u32x4 w; w.x = pk2(o[8 * i] * inv, o[8 * i + 1] * inv); w.y = pk2(o[8 * i + 2] * inv, o[8 * i + 3] * inv); w.z = pk2(o[8 * i + 4] * inv, o[8 * i + 5] * inv); w.w = pk2(o[8 * i + 6] * inv, o[8 * i + 7] * inv); op[i] = w; }
}

__device__ __forceinline__ void wave_argmax(float& v, int& i) {
#pragma unroll
    for (int o = 1; o < 64; o <<= 1) { const float ov = __shfl_xor(v, o); const int oi = __shfl_xor(i, o); if (ov > v || (ov == v && oi < i)) { v = ov; i = oi; } }
}
__global__ void __launch_bounds__(256) k_route(const bf16* __restrict__ PQ, const bf16* __restrict__ KEYS  , int* __restrict__ IDX, float* __restrict__ GATE) {
    const int lane = threadIdx.x & 63; const int gw = blockIdx.x * 4 + (threadIdx.x >> 6); const int t = gw >> 3, h = gw & 7;
    const bf16* qrow = PQ + (size_t)t * NPQ + h * 256;
    float sk[2]; int ik[2];
    const float NEG = -3.0e38f;
#pragma unroll
    for (int p = 0; p < 2; ++p) {
        float v0 = 0.f, v1 = 0.f;
        const bf16* k0 = KEYS + ((size_t)((h * 2 + p) * 128 + lane)) * 128; const bf16* k1 = k0 + 64 * 128;
#pragma unroll 4
        for (int c = 0; c < 16; ++c) {
            const u32x4 qq = *(const u32x4*)(qrow + p * 128 + 8 * c), a = *(const u32x4*)(k0 + 8 * c), bq = *(const u32x4*)(k1 + 8 * c);
            v0 += bflo(qq.x) * bflo(a.x) + bfhi(qq.x) * bfhi(a.x) + bflo(qq.y) * bflo(a.y) + bfhi(qq.y) * bfhi(a.y) + bflo(qq.z) * bflo(a.z) + bfhi(qq.z) * bfhi(a.z) + bflo(qq.w) * bflo(a.w) + bfhi(qq.w) * bfhi(a.w);
            v1 += bflo(qq.x) * bflo(bq.x) + bfhi(qq.x) * bfhi(bq.x) + bflo(qq.y) * bflo(bq.y) + bfhi(qq.y) * bfhi(bq.y) + bflo(qq.z) * bflo(bq.z) + bfhi(qq.z) * bfhi(bq.z) + bflo(qq.w) * bflo(bq.w) + bfhi(qq.w) * bfhi(bq.w);
        }
        float sr = NEG; int ir = 0;
        for (int r = 0; r < 16; ++r) {
            float bv; int bi; if (v0 >= v1) { bv = v0; bi = lane; } else { bv = v1; bi = lane + 64; }
            wave_argmax(bv, bi);
            if (lane == r) { sr = bv; ir = bi; }
            if (bi == lane) v0 = NEG; if (bi == lane + 64) v1 = NEG;
        }
        sk[p] = sr; ik[p] = ir;
    }
    float cv[4];
#pragma unroll
    for (int m = 0; m < 4; ++m) { const int c = lane + 64 * m; cv[m] = __shfl(sk[0], c >> 4) + __shfl(sk[1], c & 15); }
    float ts = NEG; int pos = 0;
    for (int r = 0; r < 16; ++r) {
        float bv = cv[0]; int bc = lane;
#pragma unroll
        for (int m = 1; m < 4; ++m) if (cv[m] > bv) { bv = cv[m]; bc = lane + 64 * m; }
        wave_argmax(bv, bc);
        if (lane == r) { ts = bv; pos = bc; }
        if ((bc & 63) == lane) { const int m = bc >> 6; if (m == 0) cv[0] = NEG; else if (m == 1) cv[1] = NEG; else if (m == 2) cv[2] = NEG; else cv[3] = NEG; }
    }
    const float mx = __shfl(ts, 0);
    const float ex = (lane < 16) ? expf(ts - mx) : 0.f;
    const float sum = wave_sum(ex);
    const int e1 = __shfl(ik[0], pos >> 4), e2 = __shfl(ik[1], pos & 15);
    if (lane < 16) { IDX[(size_t)t * 128 + h * 16 + lane] = e1 * 128 + e2; GATE[(size_t)t * 128 + h * 16 + lane] = ex / sum; }
}

__global__ void __launch_bounds__(256) k_gather(const float* xin, float* xout, const float* __restrict__ gffn, const int* __restrict__ IDX, const float* __restrict__ GATE,
                                                const bf16* __restrict__ U, const bf16* __restrict__ V) {
    const int lane = threadIdx.x & 63; const int t = blockIdx.x * 4 + (threadIdx.x >> 6);
    f32x4 xv[4], xn[4], out[4]; float s = 0.f;
#pragma unroll
    for (int j = 0; j < 4; ++j) { xv[j] = ((const f32x4*)(xin + (size_t)t * D))[64 * j + lane]; s += (xv[j].x * xv[j].x + xv[j].y * xv[j].y) + (xv[j].z * xv[j].z + xv[j].w * xv[j].w); out[j] = (f32x4){0.f, 0.f, 0.f, 0.f}; }
    const float rstd = 1.0f / sqrtf(wave_sum(s) * (1.f / D) + EPS);
#pragma unroll
    for (int j = 0; j < 4; ++j) xn[j] = xv[j] * rstd * ((const f32x4*)gffn)[64 * j + lane];
    const int* ip = IDX + (size_t)t * 128; const float* gp = GATE + (size_t)t * 128;
#pragma unroll 4
    for (int e = 0; e < 128; ++e) {
        const int row = __builtin_amdgcn_readfirstlane(ip[e]); const float gt = gp[e];
        const u32x2* ur = (const u32x2*)(U + (size_t)row * D); const u32x2* vr = (const u32x2*)(V + (size_t)row * D);
        float dot = 0.f; u32x2 vv[4];
#pragma unroll
        for (int j = 0; j < 4; ++j) { const u32x2 uu = ur[64 * j + lane]; vv[j] = vr[64 * j + lane];
            dot += xn[j].x * bflo(uu.x) + xn[j].y * bfhi(uu.x) + xn[j].z * bflo(uu.y) + xn[j].w * bfhi(uu.y); }
        const float a = wave_sum(dot);
        const float w = gt * 0.5f * a * (1.f + erff(a * 0.70710678118654752f));
#pragma unroll
        for (int j = 0; j < 4; ++j) { out[j].x += w * bflo(vv[j].x); out[j].y += w * bfhi(vv[j].x); out[j].z += w * bflo(vv[j].y); out[j].w += w * bfhi(vv[j].y); }
    }
#pragma unroll
    for (int j = 0; j < 4; ++j) ((f32x4*)(xout + (size_t)t * D))[64 * j + lane] = xv[j] + out[j];
}

extern "C" void kernel_launch(void* const* d_in, const int* in_sizes, int n_in, void* d_out, int out_size, void* d_ws, size_t ws_size, hipStream_t stream) {
    if (n_in != 18 || out_size != T * D || ws_size < WS_END) { fprintf(stderr, "kernel_launch: unexpected shapes (n_in %d out %d ws %zu)\n", n_in, out_size, ws_size); return; }
    const float* x = (const float*)d_in[0]; const float* mem = (const float*)d_in[1]; const float* g_mix = (const float*)d_in[2];
    const float* w_in_a = (const float*)d_in[3]; const float* conv_w = (const float*)d_in[4]; const float* w_in_b = (const float*)d_in[5];
    const float* w_out = (const float*)d_in[6]; const float* g_mem = (const float*)d_in[7]; const float* w_mem_kv = (const float*)d_in[8];
    const float* g_kv = (const float*)d_in[9]; const float* w_kv = (const float*)d_in[10]; const float* b_f = (const float*)d_in[11];
    const float* g_ffn = (const float*)d_in[12]; const float* peer_wq = (const float*)d_in[13]; const float* peer_keys = (const float*)d_in[14];
    const float* peer_u = (const float*)d_in[15]; const float* peer_v = (const float*)d_in[16]; const float* g_final = (const float*)d_in[17];
    unsigned char* ws = (unsigned char*)d_ws; float* out = (float*)d_out;
    bf16* WINA = (bf16*)(ws + WS_WINA); bf16* WINB = (bf16*)(ws + WS_WINB); bf16* WOUT = (bf16*)(ws + WS_WOUT); bf16* WMKV = (bf16*)(ws + WS_WMKV);
    bf16* WKV = (bf16*)(ws + WS_WKV); bf16* WPQ = (bf16*)(ws + WS_WPQ); bf16* PKEYS = (bf16*)(ws + WS_PKEYS); bf16* MN = (bf16*)(ws + WS_MN); bf16* MKV = (bf16*)(ws + WS_MKV);
    float* LOGF = (float*)(ws + WS_LOGF); float* CC2 = (float*)(ws + WS_C2); bf16* XN = (bf16*)(ws + WS_XN); bf16* XKV = (bf16*)(ws + WS_XKV);
    bf16* Z = (bf16*)(ws + WS_Z); bf16* PQ = (bf16*)(ws + WS_PQ); bf16* KV = (bf16*)(ws + WS_KV); bf16* YCAT = (bf16*)(ws + WS_YCAT);
    int* IDX = (int*)(ws + WS_IDX); float* GATE = (float*)(ws + WS_GATE); bf16* U = (bf16*)(ws + WS_U); bf16* V = (bf16*)(ws + WS_V);

    for (int l = 0; l < 2; ++l) k_transpose<<<dim3(NA / 32, D / 32), 256, 0, stream>>>(w_in_a + (size_t)l * D * NA, D, NA, WINA + (size_t)l * NA * D, NA);
    for (int l = 0; l < 2; ++l) k_transpose<<<dim3(NB / 32, D / 32), 256, 0, stream>>>(w_in_b + (size_t)l * D * NB, D, NB, WINB + (size_t)l * NB * D, NB);
    for (int l = 0; l < 4; ++l) k_transpose<<<dim3(D / 32, D / 32), 256, 0, stream>>>(w_out + (size_t)l * D * D, D, D, WOUT + (size_t)l * D * D, D);
    for (int l = 0; l < 4; ++l) k_transpose<<<dim3(512 / 32, D / 32), 256, 0, stream>>>(w_mem_kv + (size_t)l * D * 512, D, 512, WMKV + (size_t)l * 512 * D, 512);
    k_transpose<<<dim3(NKVP / 32, D / 32), 256, 0, stream>>>(w_kv, D, NKV, WKV, NKVP);
    for (int l = 0; l < 4; ++l) k_transpose<<<dim3(NPQ / 32, D / 32), 256, 0, stream>>>(peer_wq + (size_t)l * D * NPQ, D, NPQ, WPQ + (size_t)l * NPQ * D, NPQ);
    k_cvt<<<1024, 256, 0, stream>>>(peer_keys, PKEYS, (size_t)4 * 8 * 2 * 128 * 128 / 8);
    k_cvt<<<4096, 256, 0, stream>>>(peer_u, U, (size_t)4 * NEXP * D / 8);
    k_cvt<<<4096, 256, 0, stream>>>(peer_v, V, (size_t)4 * NEXP * D / 8);
    for (int l = 0; l < 4; ++l) {
        k_rmsnorm<<<2048 / 4, 256, 0, stream>>>(mem, g_mem + l * D, MN + (size_t)l * 2048 * D, nullptr, nullptr, nullptr, 2048);
        GemmEpi e{0, MKV + (size_t)l * 2048 * 512, 512, 1 << 30, 1.f, nullptr, nullptr, nullptr, nullptr};
        k_gemm<<<dim3(512 / 128, 2048 / 128), 256, 0, stream>>>(MN + (size_t)l * 2048 * D, WMKV + (size_t)l * 512 * D, 2048, 512, D, e);
    }
    k_rmsnorm<<<T / 4, 256, 0, stream>>>(x, g_mix, XN, nullptr, nullptr, nullptr, T);

    for (int l = 0; l < 4; ++l) {
        const float* xcur = (l == 0) ? x : out;
        if (l < 2) {
            GemmEpi e{0, Z, NA, 2304, C2, nullptr, nullptr, nullptr, nullptr};
            k_gemm<<<dim3(NA / 128, T / 128), 256, 0, stream>>>(XN, WINA + (size_t)l * NA * D, T, NA, D, e);
            k_conv<<<(T / 16) * 96 / 256, 256, 0, stream>>>(Z, conv_w + (size_t)l * 3 * 768, YCAT);
            k_attn_naive<<<BATCH * MEMH * SEQ / 256, 256, 0, stream>>>(Z, NA, 2304, MKV + (size_t)l * 2048 * 512, 512, 0, 256, NMEM, YCAT, D, 768, MEMH, NMEM, 0, nullptr);
        } else {
            if (l == 2) {
                GemmEpi e{2, KV, 1536, 0, 1.f, nullptr, nullptr, b_f, LOGF};
                k_gemm<<<dim3(NKVP / 128, T / 128), 256, 0, stream>>>(XKV, WKV, T, NKVP, D, e);
                k_cumsum<<<BATCH * FOXH, 64, 0, stream>>>(LOGF, CC2);
            }
            GemmEpi e{0, Z, NB, 0, C2, nullptr, nullptr, nullptr, nullptr};
            k_gemm<<<dim3(NB / 128, T / 128), 256, 0, stream>>>(XN, WINB + (size_t)(l - 2) * NB * D, T, NB, D, e);
            k_attn_naive<<<BATCH * FOXH * SEQ / 256, 256, 0, stream>>>(Z, NB, 0, KV, 1536, 0, 768, SEQ, YCAT, D, 0, FOXH, SEQ, 1, CC2);
            k_attn_naive<<<BATCH * MEMH * SEQ / 256, 256, 0, stream>>>(Z, NB, 768, MKV + (size_t)l * 2048 * 512, 512, 0, 256, NMEM, YCAT, D, 768, MEMH, NMEM, 0, nullptr);
        }
        { GemmEpi e{1, nullptr, D, 0, 1.f, xcur, out, nullptr, nullptr};
          k_gemm<<<dim3(D / 128, T / 128), 256, 0, stream>>>(YCAT, WOUT + (size_t)l * D * D, T, D, D, e); }
        k_rmsnorm<<<T / 4, 256, 0, stream>>>(out, g_ffn + l * D, XN, nullptr, nullptr, nullptr, T);
        { GemmEpi e{0, PQ, NPQ, 1 << 30, 1.f, nullptr, nullptr, nullptr, nullptr};
          k_gemm<<<dim3(NPQ / 128, T / 128), 256, 0, stream>>>(XN, WPQ + (size_t)l * NPQ * D, T, NPQ, D, e); }
        k_route<<<T * PH / 4, 256, 0, stream>>>(PQ, PKEYS + (size_t)l * 8 * 2 * 128 * 128, IDX, GATE);
        k_gather<<<T / 4, 256, 0, stream>>>(out, out, g_ffn + l * D, IDX, GATE, U + (size_t)l * NEXP * D, V + (size_t)l * NEXP * D);
        if (l < 3) k_rmsnorm<<<T / 4, 256, 0, stream>>>(out, g_mix + (l + 1) * D, XN, (l == 1) ? g_kv : nullptr, (l == 1) ? XKV : nullptr, nullptr, T);
        else k_rmsnorm<<<T / 4, 256, 0, stream>>>(out, g_final, nullptr, nullptr, nullptr, out, T);
    }
}
```

```cpp
#include <hip/hip_runtime.h>
#include <cstdio>
#include <cstdint>

constexpr int BATCH = 8, SEQ = 4096, T = BATCH * SEQ, D = 1024;
constexpr int NA = 2560, NB = 1024, NKV = 1548, NKVP = 1792, NPQ = 2048, NMEM = 256;
constexpr int FOXH = 12, MEMH = 4, PH = 8, PK = 16, NEXP = 16384;
constexpr float EPS = 1e-6f;
constexpr float C2 = 0.125f * 1.4426950408889634f;
constexpr float LOG2E = 1.4426950408889634f;


namespace pg8 {
#define PG8_LAS __attribute__((address_space(3)))
typedef unsigned short bf16_t;
typedef short bf16x8 __attribute__((ext_vector_type(8)));
typedef float f32x4 __attribute__((ext_vector_type(4)));
typedef unsigned u32x4 __attribute__((ext_vector_type(4)));
constexpr int BM = 256, BK = 64, HALF = 128, HTB = HALF * BK * 2  , STAGE_BYTES = 8 * HTB, NXCD = 8, WGM = 8;

__host__ __device__ __forceinline__ int lds_byte(int r, int c) { const int st = (r >> 4) * 2 + (c >> 5), rr = r & 15, cc = c & 31, ob = rr * 64 + cc * 2; return st * 1024 + (ob ^ (((ob >> 9) & 1) << 5)); }
__host__ __device__ __forceinline__ void stage_rc(int b, int& R, int& C) { const int st = b / 1024, sb = b % 1024, swz = sb ^ (((sb >> 9) & 1) << 5); R = (st >> 1) * 16 + swz / 64; C = (st & 1) * 32 + (swz % 64) / 2; }
__host__ __device__ __forceinline__ int perm32(int rho) { const int n = rho >> 4, i = rho & 15; return 8 * (i >> 2) + 4 * n + (i & 3); }

struct Unit { int pm, pn; };
struct Gemm { const bf16_t* A; const bf16_t* Bt; int M, N, K; };

struct StaticOrder {
    int nM, nN, nwg, G, c;
    __host__ __device__ void init(int M, int N, int G_, int c_) { nM = M / BM; nN = N / BM; nwg = nM * nN; G = G_; c = c_; }
    __host__ __device__ bool next(int i, Unit& u) const {
        const long L = (long)i * G + c; if (L >= nwg) return false;
        int wgid = (int)L; { const int q = nwg / NXCD, r = nwg % NXCD, xcd = wgid % NXCD, off = wgid / NXCD; wgid = (xcd < r ? xcd * (q + 1) : r * (q + 1) + (xcd - r) * q) + off; }
        const int nig = WGM * nN, gid = wgid / nig, fm = gid * WGM, gsz = (nM - fm) < WGM ? (nM - fm) : WGM;
        u.pm = fm + ((wgid % nig) % gsz); u.pn = (wgid % nig) / gsz; return true;
    }
    __device__ __forceinline__ void a_ready(const Unit&) const {}
    __device__ __forceinline__ void done(const Unit&) const {}
};

__device__ __forceinline__ unsigned cvt_pk_bf16(float lo, float hi) { unsigned r; asm volatile("v_cvt_pk_bf16_f32 %0, %1, %2" : "=v"(r) : "v"(lo), "v"(hi)); return r; }

__device__ __forceinline__ void row_rstd(float (&rs)[2][4], const float* ssq, int nslots, int row0) {
#pragma unroll
    for (int ai = 0; ai < 2; ++ai)
#pragma unroll
        for (int m = 0; m < 4; ++m) {
            if (ssq) { const f32x4* sp = (const f32x4*)(ssq + (size_t)(row0 + ai * HALF + m * 16) * 16); const f32x4 a = sp[0], b = sp[1]; float s = ((a[0] + a[1]) + (a[2] + a[3])) + ((b[0] + b[1]) + (b[2] + b[3]));
                if (nslots == 16) { const f32x4 c = sp[2], d = sp[3]; s += ((c[0] + c[1]) + (c[2] + c[3])) + ((d[0] + d[1]) + (d[2] + d[3])); }
                rs[ai][m] = 1.0f / sqrtf(s * (1.f / 1024.f) + EPS); }
            else rs[ai][m] = 1.f;
        }
}
struct EpiStore {
    static constexpr bool PERM = true, AFTER_DRAIN = false;
    bf16_t* O; int ldc; int wrap; int scale_from; float scale; const float* ssq; int nslots;
    __device__ __forceinline__ void operator()(const f32x4 (&acc)[2][2][4][2], const Unit& u, int wr, int wc, int fr, int fq) const {
        const int row0 = u.pm * BM + wr * 64 + fr; const int colt = (u.pn * BM) % wrap;
        const float sc = (u.pn * BM >= scale_from) ? scale : 1.f;
        const int col0 = colt + wc * 32 + 8 * fq;
        float rs[2][4]; row_rstd(rs, ssq, nslots, row0);
#pragma unroll
        for (int ai = 0; ai < 2; ++ai)
#pragma unroll
            for (int m = 0; m < 4; ++m) { bf16_t* rowp = O + (size_t)(row0 + ai * HALF + m * 16) * ldc + col0; const float f = sc * rs[ai][m];
#pragma unroll
                for (int bj = 0; bj < 2; ++bj) { const f32x4 v0 = acc[ai][bj][m][0] * f, v1 = acc[ai][bj][m][1] * f;
                    u32x4 w; w.x = cvt_pk_bf16(v0[0], v0[1]); w.y = cvt_pk_bf16(v0[2], v0[3]); w.z = cvt_pk_bf16(v1[0], v1[1]); w.w = cvt_pk_bf16(v1[2], v1[3]);
                    *(u32x4*)(rowp + bj * HALF) = w; } }
    }
};
struct EpiResid {
    static constexpr bool PERM = true, AFTER_DRAIN = false;
    bf16_t* X; int ldc; float* ssq;
    __device__ __forceinline__ void operator()(const f32x4 (&acc)[2][2][4][2], const Unit& u, int wr, int wc, int fr, int fq) const {
        const int row0 = u.pm * BM + wr * 64 + fr; const int col0 = u.pn * BM + wc * 32 + 8 * fq;
#pragma unroll
        for (int ai = 0; ai < 2; ++ai)
#pragma unroll
            for (int m = 0; m < 4; ++m) { const int row = row0 + ai * HALF + m * 16; const size_t off = (size_t)row * ldc + col0; float q = 0.f;
                u32x4 rv[2];
#pragma unroll
                for (int bj = 0; bj < 2; ++bj) rv[bj] = *(const u32x4*)(X + off + bj * HALF);
#pragma unroll
                for (int bj = 0; bj < 2; ++bj) {
                    const f32x4 r0 = {__uint_as_float(rv[bj].x << 16), __uint_as_float(rv[bj].x & 0xffff0000u), __uint_as_float(rv[bj].y << 16), __uint_as_float(rv[bj].y & 0xffff0000u)};
                    const f32x4 r1 = {__uint_as_float(rv[bj].z << 16), __uint_as_float(rv[bj].z & 0xffff0000u), __uint_as_float(rv[bj].w << 16), __uint_as_float(rv[bj].w & 0xffff0000u)};
                    const f32x4 o0 = r0 + acc[ai][bj][m][0], o1 = r1 + acc[ai][bj][m][1];
                    q += ((o0[0] * o0[0] + o0[1] * o0[1]) + (o0[2] * o0[2] + o0[3] * o0[3])) + ((o1[0] * o1[0] + o1[1] * o1[1]) + (o1[2] * o1[2] + o1[3] * o1[3]));
                    u32x4 w; w.x = cvt_pk_bf16(o0[0], o0[1]); w.y = cvt_pk_bf16(o0[2], o0[3]); w.z = cvt_pk_bf16(o1[0], o1[1]); w.w = cvt_pk_bf16(o1[2], o1[3]);
                    *(u32x4*)(X + off + bj * HALF) = w; }
                q += __shfl_xor(q, 16); q += __shfl_xor(q, 32);
                if (fq == 0) ssq[(size_t)row * 16 + u.pn * 4 + wc] = q;
                if (m & 1) asm volatile("" ::: "memory"); }
    }
};
struct EpiKV {
    static constexpr bool PERM = true, AFTER_DRAIN = false;
    bf16_t* KV; const float* b_f; float* logf; const float* ssq; int nslots;
    __device__ __forceinline__ void operator()(const f32x4 (&acc)[2][2][4][2], const Unit& u, int wr, int wc, int fr, int fq) const {
        const int row0 = u.pm * BM + wr * 64 + fr;
        float rs[2][4]; row_rstd(rs, ssq, nslots, row0);
        if (u.pn < 6) {
            const int col0 = u.pn * BM + wc * 32 + 8 * fq;
#pragma unroll
            for (int ai = 0; ai < 2; ++ai)
#pragma unroll
                for (int m = 0; m < 4; ++m) { bf16_t* rowp = KV + (size_t)(row0 + ai * HALF + m * 16) * 1536 + col0;
#pragma unroll
                    for (int bj = 0; bj < 2; ++bj) { const f32x4 v0 = acc[ai][bj][m][0] * rs[ai][m], v1 = acc[ai][bj][m][1] * rs[ai][m];
                        u32x4 w; w.x = cvt_pk_bf16(v0[0], v0[1]); w.y = cvt_pk_bf16(v0[2], v0[3]); w.z = cvt_pk_bf16(v1[0], v1[1]); w.w = cvt_pk_bf16(v1[2], v1[3]);
                        *(u32x4*)(rowp + bj * HALF) = w; } }
        } else if (wc == 0 && fq < 2) {
#pragma unroll
            for (int ai = 0; ai < 2; ++ai)
#pragma unroll
                for (int m = 0; m < 4; ++m) { const int row = row0 + ai * HALF + m * 16; const int b = row / SEQ, s = row % SEQ;
#pragma unroll
                    for (int n = 0; n < 2; ++n)
#pragma unroll
                        for (int q = 0; q < 4; ++q) { const int col = 8 * fq + 4 * n + q;
                            if (col < FOXH) { const float z = acc[ai][0][m][n][q] * rs[ai][m] + b_f[col]; const float ls = fminf(z, 0.f) - log1pf(expf(-fabsf(z)));
                                logf[((size_t)(b * FOXH + col)) * SEQ + s] = ls; } } }
        }
    }
};
struct MemKvOrder {
    int G, c;
    __device__ bool next(int i, Unit& u) const { const int L = i * G + c; if (L >= 64) return false; const int layer = L >> 4, r = L & 15; u.pm = layer * 8 + (r >> 1); u.pn = layer * 2 + (r & 1); return true; }
    __device__ __forceinline__ void a_ready(const Unit&) const {}
    __device__ __forceinline__ void done(const Unit&) const {}
};


template <class Epi, class Sched, bool ALIGN_EPI = false, bool SP2 = false>
__device__ __forceinline__ void gemm_phase(PG8_LAS unsigned char* lds, const Gemm g, const Sched& S, const Epi& E) {
    int tid_ = threadIdx.x; asm volatile("" : "+v"(tid_));
    const int tid = tid_, wid = __builtin_amdgcn_readfirstlane(tid >> 6), lane = tid & 63, wr = wid >> 2, wc = wid & 3, fr = lane & 15, fq = lane >> 4;
    const int K = g.K, nt = K / BK;
    unsigned voffA[2], voffB[2];
#pragma unroll
    for (int i = 0; i < 2; ++i) { int R, C; stage_rc(tid * 16 + i * 8192, R, C); const int Rb = Epi::PERM ? ((R & ~31) + perm32(R & 31)) : R;
        voffA[i] = (unsigned)(R * K + C) * 2u; voffB[i] = (unsigned)(Rb * K + C) * 2u; }
    const size_t kstep = (size_t)(BK * 2);
    const size_t hstep = (size_t)HALF * K * 2;
    const size_t tstep = 2 * hstep;
    const unsigned ldsw = (unsigned)wid * 1024u;
    const int aoff = lds_byte(wr * 64 + fr, fq * 8), boff = lds_byte(wc * 32 + fr, fq * 8);
#define PG8_SA(b, h) (((b) * 2 + (h)) * HTB)
#define PG8_SB(b, h) ((4 + (b) * 2 + (h)) * HTB)
#define PG8_STAGE(bufoff, gbase, voff) do { _Pragma("unroll") for (int _i = 0; _i < 2; ++_i) \
        __builtin_amdgcn_global_load_lds((const unsigned*)((const char*)(gbase) + (voff)[_i]), (PG8_LAS unsigned*)(lds + (bufoff) + ldsw + _i * 8192), 16, 0, 0); } while (0)
#define PG8_LDA(dst, b, h) do { _Pragma("unroll") for (int m = 0; m < 4; ++m) _Pragma("unroll") for (int k = 0; k < 2; ++k) dst[m][k] = *(const PG8_LAS bf16x8*)(lds + PG8_SA(b, h) + aoff + m * 2048 + k * 1024); } while (0)
#define PG8_LDB(dst, b, h) do { _Pragma("unroll") for (int n = 0; n < 2; ++n) _Pragma("unroll") for (int k = 0; k < 2; ++k) dst[n][k] = *(const PG8_LAS bf16x8*)(lds + PG8_SB(b, h) + boff + n * 2048 + k * 1024); } while (0)
#define PG8_MMA(ai, bj, At, Bt) do { __builtin_amdgcn_s_setprio(1); _Pragma("unroll") for (int m = 0; m < 4; ++m) _Pragma("unroll") for (int n = 0; n < 2; ++n) _Pragma("unroll") for (int k = 0; k < 2; ++k) \
        acc[ai][bj][m][n] = __builtin_amdgcn_mfma_f32_16x16x32_bf16(Bt[n][k], At[m][k], acc[ai][bj][m][n], 0, 0, 0); __builtin_amdgcn_s_setprio(0); } while (0)
#define PG8_WAIT_V(n) asm volatile("s_waitcnt vmcnt(" #n ")" ::: "memory")
#define PG8_WAIT_L(n) asm volatile("s_waitcnt lgkmcnt(" #n ")" ::: "memory")
#define PG8_BAR __builtin_amdgcn_s_barrier()
#define PG8_SCHED __builtin_amdgcn_sched_barrier(0)
    Unit cur, nxt; int ui = 0;
    if (!S.next(0, cur)) return;
    f32x4 acc[2][2][4][2];
#pragma unroll
    for (int a = 0; a < 2; ++a)
#pragma unroll
        for (int b = 0; b < 2; ++b)
#pragma unroll
            for (int m = 0; m < 4; ++m)
#pragma unroll
                for (int n = 0; n < 2; ++n) acc[a][b][m][n] = (f32x4){0.f, 0.f, 0.f, 0.f};
    bf16x8 At[4][2], B0[2][2], B1[2][2];
    const char* cA = (const char*)g.A + (size_t)cur.pm * tstep; const char* cB = (const char*)g.Bt + (size_t)cur.pn * tstep;
    S.a_ready(cur);
    if constexpr (SP2) {
        PG8_STAGE(PG8_SB(0, 0), cB, voffB); PG8_STAGE(PG8_SB(0, 1), cB + hstep, voffB); PG8_STAGE(PG8_SA(0, 0), cA, voffA); PG8_STAGE(PG8_SA(0, 1), cA + hstep, voffA);
        if (wr == 1) PG8_BAR;
        PG8_WAIT_V(2); PG8_BAR;
        PG8_STAGE(PG8_SB(1, 0), cB + kstep, voffB); PG8_STAGE(PG8_SA(1, 0), cA + kstep, voffA); PG8_STAGE(PG8_SB(1, 1), cB + hstep + kstep, voffB);
        PG8_WAIT_V(6); PG8_BAR;
    } else {
        PG8_STAGE(PG8_SB(0, 0), cB, voffB); PG8_STAGE(PG8_SA(0, 0), cA, voffA); PG8_STAGE(PG8_SB(0, 1), cB + hstep, voffB); PG8_STAGE(PG8_SA(0, 1), cA + hstep, voffA);
        if (wr == 1) PG8_BAR;
        PG8_WAIT_V(4); PG8_BAR;
        PG8_STAGE(PG8_SB(1, 0), cB + kstep, voffB); PG8_STAGE(PG8_SA(1, 0), cA + kstep, voffA); PG8_STAGE(PG8_SB(1, 1), cB + hstep + kstep, voffB);
        PG8_WAIT_V(6); PG8_BAR;
    }
    for (;;) {
        const bool has_next = S.next(ui + 1, nxt);
        const char* nA = has_next ? (const char*)g.A + (size_t)nxt.pm * tstep : cA; const char* nB = has_next ? (const char*)g.Bt + (size_t)nxt.pn * tstep : cB;
        for (int t = 0; t < nt; t += 2) {
            const bool last = (t == nt - 2);
            const char* a1 = cA + (size_t)(t + 1) * kstep;
            const char* a2 = last ? nA : cA + (size_t)(t + 2) * kstep; const char* b2 = last ? nB : cB + (size_t)(t + 2) * kstep;
            const char* a3 = a2 + kstep; const char* b3 = b2 + kstep;
            if (last && has_next) S.a_ready(nxt);
            if constexpr (SP2) {
            PG8_LDB(B0, 0, 0); PG8_LDB(B1, 0, 1); PG8_SCHED; PG8_LDA(At, 0, 0); PG8_STAGE(PG8_SA(1, 1), a1 + hstep, voffA);
            PG8_WAIT_V(8); PG8_WAIT_L(0); PG8_BAR; PG8_MMA(0, 0, At, B0); PG8_MMA(0, 1, At, B1); PG8_BAR; PG8_SCHED;
            PG8_LDA(At, 0, 1); PG8_STAGE(PG8_SB(0, 0), b2, voffB); PG8_STAGE(PG8_SB(0, 1), b2 + hstep, voffB); PG8_STAGE(PG8_SA(0, 0), a2, voffA);
            PG8_WAIT_V(8); PG8_WAIT_L(0); PG8_BAR; PG8_MMA(1, 0, At, B0); PG8_MMA(1, 1, At, B1); PG8_BAR; PG8_SCHED;
            PG8_LDB(B0, 1, 0); PG8_LDB(B1, 1, 1); PG8_SCHED; PG8_LDA(At, 1, 0); PG8_STAGE(PG8_SA(0, 1), a2 + hstep, voffA);
            PG8_WAIT_V(8); PG8_WAIT_L(0); PG8_BAR; PG8_MMA(0, 0, At, B0); PG8_MMA(0, 1, At, B1); PG8_BAR; PG8_SCHED;
            PG8_LDA(At, 1, 1); PG8_STAGE(PG8_SB(1, 0), b3, voffB); PG8_STAGE(PG8_SB(1, 1), b3 + hstep, voffB); PG8_STAGE(PG8_SA(1, 0), a3, voffA);
            PG8_WAIT_V(8); PG8_WAIT_L(0); PG8_BAR; PG8_MMA(1, 0, At, B0); PG8_MMA(1, 1, At, B1); PG8_BAR; PG8_SCHED;
            } else {
            PG8_LDB(B0, 0, 0); PG8_SCHED; PG8_LDA(At, 0, 0); PG8_STAGE(PG8_SA(1, 1), a1 + hstep, voffA);
            PG8_WAIT_L(8); PG8_BAR; PG8_WAIT_L(0); PG8_MMA(0, 0, At, B0); PG8_BAR; PG8_SCHED;
            PG8_LDB(B1, 0, 1); PG8_STAGE(PG8_SB(0, 0), b2, voffB);
            PG8_BAR; PG8_WAIT_L(0); PG8_MMA(0, 1, At, B1); PG8_BAR;
            PG8_LDA(At, 0, 1); PG8_STAGE(PG8_SA(0, 0), a2, voffA);
            PG8_BAR; PG8_WAIT_L(0); PG8_MMA(1, 0, At, B0); PG8_BAR; PG8_SCHED;
            PG8_STAGE(PG8_SB(0, 1), b2 + hstep, voffB);
            PG8_WAIT_V(6); PG8_BAR; PG8_MMA(1, 1, At, B1); PG8_BAR;
            PG8_LDB(B0, 1, 0); PG8_SCHED; PG8_LDA(At, 1, 0); PG8_STAGE(PG8_SA(0, 1), a2 + hstep, voffA);
            PG8_WAIT_L(8); PG8_BAR; PG8_WAIT_L(0); PG8_MMA(0, 0, At, B0); PG8_BAR; PG8_SCHED;
            PG8_LDB(B1, 1, 1); PG8_STAGE(PG8_SB(1, 0), b3, voffB);
            PG8_BAR; PG8_WAIT_L(0); PG8_MMA(0, 1, At, B1); PG8_BAR;
            PG8_LDA(At, 1, 1); PG8_STAGE(PG8_SA(1, 0), a3, voffA);
            PG8_BAR; PG8_WAIT_L(0); PG8_MMA(1, 0, At, B0); PG8_BAR; PG8_SCHED;
            PG8_STAGE(PG8_SB(1, 1), b3 + hstep, voffB);
            PG8_WAIT_V(6); PG8_BAR; PG8_MMA(1, 1, At, B1); PG8_BAR;
            }
        }
        if constexpr (ALIGN_EPI) { if (wr == 0) PG8_BAR; }
        if constexpr (!Epi::AFTER_DRAIN) { E(acc, cur, wr, wc, fr, fq); S.done(cur); }
        if (!has_next) break;
#pragma unroll
        for (int a = 0; a < 2; ++a)
#pragma unroll
            for (int b = 0; b < 2; ++b)
#pragma unroll
                for (int m = 0; m < 4; ++m)
#pragma unroll
                    for (int n = 0; n < 2; ++n) acc[a][b][m][n] = (f32x4){0.f, 0.f, 0.f, 0.f};
        cur = nxt; cA = nA; cB = nB; ++ui;
        if constexpr (ALIGN_EPI) { if (wr == 1) PG8_BAR; }
    }
    PG8_WAIT_V(0);
    if constexpr (!ALIGN_EPI) { if (wr == 0) PG8_BAR; }
    PG8_BAR;
    if constexpr (Epi::AFTER_DRAIN) { E.fused(acc, cur, wr, wc, fr, fq, lds, wid, lane); S.done(cur); }
#undef PG8_SA
#undef PG8_SB
#undef PG8_STAGE
#undef PG8_LDA
#undef PG8_LDB
#undef PG8_MMA
#undef PG8_WAIT_V
#undef PG8_WAIT_L
#undef PG8_BAR
#undef PG8_SCHED
}
}
#define GAS __attribute__((address_space(1)))
#define LAS __attribute__((address_space(3)))
typedef unsigned short bf16;
typedef unsigned v4u __attribute__((ext_vector_type(4)));
typedef float f32x4 __attribute__((ext_vector_type(4)));
typedef short bf16x8 __attribute__((ext_vector_type(8)));
typedef GAS unsigned gu32;
typedef GAS unsigned long long gu64;
#define RLX_AGENT __ATOMIC_RELAXED, __HIP_MEMORY_SCOPE_AGENT
#define LDS_WAIT() asm volatile("s_waitcnt lgkmcnt(0)" ::: "memory")
#define VM_WAIT() asm volatile("s_waitcnt vmcnt(0)" ::: "memory")
__device__ __forceinline__ unsigned long long rt() { return __builtin_amdgcn_s_memrealtime(); }
__device__ __forceinline__ unsigned f2bf(float f) { unsigned u = __builtin_bit_cast(unsigned, f); return (u + 0x7fffu + ((u >> 16) & 1u)) >> 16; }
__device__ __forceinline__ unsigned pk2(float lo, float hi) { return f2bf(lo) | (f2bf(hi) << 16); }

#define XB_TMO      128
#define XB_XCNT(j)  (256  + 64 * (j))
#define XB_XSUB(j)  (1280 + 64 * (j))
#define XB_XGEN(j)  (2304 + 64 * (j))
#define XB_TOP      3328
#define XB_TOPGEN   3392
#define XCD_BAR_WORDS 3456
#define XB_SPIN_CAP (1u << 18)

__device__ __forceinline__ unsigned xb_ld(unsigned* p)              { return __hip_atomic_load(p, __ATOMIC_RELAXED, __HIP_MEMORY_SCOPE_AGENT); }
__device__ __forceinline__ unsigned xb_add(unsigned* p, unsigned v) { return __hip_atomic_fetch_add(p, v, __ATOMIC_RELAXED, __HIP_MEMORY_SCOPE_AGENT); }
__device__ __forceinline__ unsigned xb_xcc_id() { return (unsigned)__builtin_amdgcn_s_getreg((3 << 11) | 20) & 0xFu; }
#define XB_SPIN(cond, bar) do { unsigned _sp = 0; while (cond) { __builtin_amdgcn_s_sleep(1); \
    if ((++_sp & 255u) == 0u) { if (xb_ld(&(bar)[XB_TMO])) break; if (_sp > XB_SPIN_CAP) { atomicAdd(&(bar)[XB_TMO], 1u); break; } } } } while (0)

struct XcdBarrier {
    unsigned* bar; unsigned x;
    volatile LAS unsigned* st;
};

__device__ __forceinline__ XcdBarrier xcd_barrier_post(unsigned* bar, volatile LAS unsigned* st) {
    XcdBarrier b; b.bar = bar; b.x = xb_xcc_id(); b.st = st;
    if (threadIdx.x == 0) (void)xb_add(&bar[XB_XCNT(b.x)], 1u);
    return b;
}
__device__ __forceinline__ void xcd_barrier_complete(unsigned* bar, unsigned x, unsigned& nloc, unsigned& nx) {
    const unsigned G = gridDim.x * gridDim.y * gridDim.z;
    unsigned sum, cnt, mine, sp = 0u;
    for (;;) {
        sum = 0u; cnt = 0u; mine = 0u;
#pragma unroll
        for (unsigned j = 0; j < 16; ++j) { const unsigned c = xb_ld(&bar[XB_XCNT(j)]); sum += c; cnt += (c > 0u) ? 1u : 0u; mine = (j == x) ? c : mine; }
        if (sum == G) break;
        __builtin_amdgcn_s_sleep(1);
        if ((++sp & 255u) == 0u) { if (xb_ld(&bar[XB_TMO])) break; if (sp > XB_SPIN_CAP) { atomicAdd(&bar[XB_TMO], 1u); break; } }
    }
    nloc = mine > 0u ? mine : 1u; nx = cnt > 0u ? cnt : 1u;
}

__device__ __forceinline__ void xcd_barrier(const XcdBarrier& b) {
    asm volatile("s_waitcnt vmcnt(0)" ::: "memory");
    __syncthreads();
    if (threadIdx.x == 0) {
        unsigned* bar = b.bar;
        __builtin_amdgcn_s_waitcnt(0);
        unsigned nloc = b.st[0], nx = b.st[1];
        if (nloc == 0u) { xcd_barrier_complete(bar, b.x, nloc, nx); b.st[0] = nloc; b.st[1] = nx; }
        const unsigned old = xb_add(&bar[XB_XSUB(b.x)], 1u);
        const unsigned gen = old / nloc;
        if (old + 1u == (gen + 1u) * nloc) {
            __builtin_amdgcn_fence(__ATOMIC_RELEASE, "agent");
            asm volatile("s_waitcnt vmcnt(0)" ::: "memory");
            const unsigned og = xb_add(&bar[XB_TOP], 1u);
            const unsigned tg = og / nx;
            if (og + 1u == (tg + 1u) * nx) xb_add(&bar[XB_TOPGEN], 1u);
            else XB_SPIN(xb_ld(&bar[XB_TOPGEN]) == tg, bar);
            __builtin_amdgcn_fence(__ATOMIC_ACQUIRE, "agent");
            xb_add(&bar[XB_XGEN(b.x)], 1u);
            asm volatile("s_waitcnt vmcnt(0)" ::: "memory");
        } else {
            XB_SPIN(xb_ld(&bar[XB_XGEN(b.x)]) == gen, bar);
            __builtin_amdgcn_fence(__ATOMIC_ACQUIRE, "agent");
            asm volatile("s_waitcnt vmcnt(0)" ::: "memory");
        }
    }
    __syncthreads();
}

typedef float f32x16 __attribute__((ext_vector_type(16)));
typedef unsigned u32x4 __attribute__((ext_vector_type(4)));
typedef unsigned u32x2 __attribute__((ext_vector_type(2)));
__device__ __forceinline__ float bflo(unsigned u) { return __uint_as_float(u << 16); }
__device__ __forceinline__ float bfhi(unsigned u) { return __uint_as_float(u & 0xffff0000u); }
__device__ __forceinline__ int crow(int r, int hi) { return (r & 3) + 8 * (r >> 2) + 4 * hi; }
__device__ __forceinline__ float wave_sum(float v) {
#pragma unroll
    for (int o = 1; o < 64; o <<= 1) v += __shfl_xor(v, o);
    return v;
}


#include <hip/hip_bf16.h>
#include <cmath>
namespace attn_body {
using bf16=__hip_bfloat16;
using bf16x8=__attribute__((ext_vector_type(8)))short;
using s16x4=__attribute__((ext_vector_type(4)))short;
using f32x16=__attribute__((ext_vector_type(16)))float;
using u32x4=__attribute__((ext_vector_type(4)))unsigned;
constexpr int D=64;
constexpr int NW=8,QBLK=32,QB=QBLK*NW,KVBLK=64;
constexpr int ATTN_UNIT_ROWS=QB;
__device__ __forceinline__ int crow(int r,int hi){return (r&3)+8*(r>>2)+4*hi;}
#define SBAR() __builtin_amdgcn_sched_barrier(0)
__device__ __forceinline__ void cmask(f32x16&p0,f32x16&p1,int jb,int qrel,int hi){
  const float NEG=-INFINITY; int kb=64*jb+4*hi;
  #pragma unroll
  for(int r=0;r<16;++r){int kv=kb+(r&3)+8*(r>>2); if(kv>qrel)p0[r]=NEG; if(kv+32>qrel)p1[r]=NEG;}
}

constexpr int NSLOT=3, SLOTB=8192;
constexpr int LDS_K=0, LDS_V=NSLOT*SLOTB, LDS_WS=2*NSLOT*SLOTB, LDS_OST=LDS_WS+NW*64*4, LDS_CS=LDS_OST+NW*4096, LDS_BYTES=LDS_CS+4096*4;
constexpr float C2=0.125f*1.4426950408889634f;
__device__ __forceinline__ void glds16(const void*gsrc,unsigned lds_dst){unsigned keep;
  asm volatile("s_mov_b32 %0, m0\n\ts_mov_b32 m0, %2\n\ts_nop 0\n\tglobal_load_lds_dwordx4 %1, off\n\ts_mov_b32 m0, %0":"=&s"(keep):"v"(gsrc),"s"(lds_dst):"memory");}
__device__ __forceinline__ float max3f(float a,float b,float c){float r;asm("v_max3_f32 %0, %1, %2, %3":"=v"(r):"v"(a),"v"(b),"v"(c));return r;}
__device__ __forceinline__ float max2f(float a,float b){float r;asm("v_max_f32_e32 %0, %1, %2":"=v"(r):"v"(a),"v"(b));return r;}
__device__ __forceinline__ float fadd_s(float a,float b){float r;asm("v_add_f32_e32 %0, %1, %2":"=v"(r):"v"(a),"v"(b));return r;}
__device__ __forceinline__ float fsub_s(float a,float b){float r;asm("v_sub_f32_e32 %0, %1, %2":"=v"(r):"v"(a),"v"(b));return r;}
typedef float f32x2_t __attribute__((ext_vector_type(2))); typedef __bf16 bf16x2_t __attribute__((ext_vector_type(2))); typedef float f32x4_t __attribute__((ext_vector_type(4)));
__device__ __forceinline__ unsigned cvtpk_s(float lo,float hi){f32x2_t v={lo,hi};bf16x2_t b=__builtin_convertvector(v,bf16x2_t);return __builtin_bit_cast(unsigned,b);}
#define WAIT_BAR(N) asm volatile("s_waitcnt vmcnt(" #N ") lgkmcnt(0)\n\ts_barrier":::"memory")

__device__ __forceinline__ void qkt(f32x16&p0,f32x16&p1,const char*Kslot,const bf16x8*qr,const f32x16&ci0,const f32x16&ci1,int r32,int hi){
  const char*kb=Kslot+hi*1024+r32*16;
  #pragma unroll
  for(int d0=0;d0<4;++d0){
    const bf16x8 b0=*reinterpret_cast<const bf16x8*>(kb+d0*2048);
    const bf16x8 b1=*reinterpret_cast<const bf16x8*>(kb+d0*2048+512);
    if(d0==0){p0=__builtin_amdgcn_mfma_f32_32x32x16_bf16(b0,qr[0],ci0,0,0,0);p1=__builtin_amdgcn_mfma_f32_32x32x16_bf16(b1,qr[0],ci1,0,0,0);}
    else{p0=__builtin_amdgcn_mfma_f32_32x32x16_bf16(b0,qr[d0],p0,0,0,0);p1=__builtin_amdgcn_mfma_f32_32x32x16_bf16(b1,qr[d0],p1,0,0,0);}}
}
typedef __attribute__((address_space(3))) const char* lds_cptr;
typedef short v4i16_t __attribute__((ext_vector_type(4)));
__device__ __forceinline__ void kload8(bf16x8*kf,lds_cptr kp){
  kf[0]=*(const __attribute__((address_space(3))) bf16x8*)(kp);      kf[1]=*(const __attribute__((address_space(3))) bf16x8*)(kp+512);
  kf[2]=*(const __attribute__((address_space(3))) bf16x8*)(kp+2048); kf[3]=*(const __attribute__((address_space(3))) bf16x8*)(kp+2560);
  kf[4]=*(const __attribute__((address_space(3))) bf16x8*)(kp+4096); kf[5]=*(const __attribute__((address_space(3))) bf16x8*)(kp+4608);
  kf[6]=*(const __attribute__((address_space(3))) bf16x8*)(kp+6144); kf[7]=*(const __attribute__((address_space(3))) bf16x8*)(kp+6656);
}
__device__ __forceinline__ void kload2(bf16x8*kf,lds_cptr kp,int j){ kf[2*j]=*(const __attribute__((address_space(3))) bf16x8*)(kp+j*2048); kf[2*j+1]=*(const __attribute__((address_space(3))) bf16x8*)(kp+j*2048+512); }
__device__ __forceinline__ s16x4 vtr(lds_cptr p){ return __builtin_bit_cast(s16x4,__builtin_amdgcn_ds_read_tr16_b64_v4i16((__attribute__((address_space(3))) v4i16_t*)p)); }
__device__ __forceinline__ float rowmax(const f32x16&p0,const f32x16&p1){
  float a=max3f(p0[0],p0[1],p1[0]),b=max3f(p0[2],p0[3],p1[1]);a=max3f(a,p1[2],p1[3]);
  #pragma unroll
  for(int r=4;r<16;r+=4){a=max3f(a,p0[r],p0[r+1]);b=max3f(b,p0[r+2],p0[r+3]);a=max3f(a,p1[r],p1[r+1]);b=max3f(b,p1[r+2],p1[r+3]);}
  const float m=max2f(a,b);
  auto rr=__builtin_amdgcn_permlane32_swap(__float_as_uint(m),__float_as_uint(m),false,false);
  return max2f(__uint_as_float(rr[0]),__uint_as_float(rr[1]));
}
__device__ __forceinline__ void pv(f32x16*o,int vb,bf16x8 pa0,bf16x8 pa1,bf16x8 pa2,bf16x8 pa3){
  #pragma unroll
  for(int d0=0;d0<2;++d0){s16x4 lo[4],hi[4];
    #pragma unroll
    for(int ks=0;ks<4;++ks){
      asm volatile("ds_read_b64_tr_b16 %0,%1 offset:%c2":"=&v"(lo[ks]):"v"(vb),"i"(d0*4096+ks*1024):"memory");
      asm volatile("ds_read_b64_tr_b16 %0,%1 offset:%c2":"=&v"(hi[ks]):"v"(vb),"i"(d0*4096+ks*1024+512):"memory");}
    asm volatile("s_waitcnt lgkmcnt(0)":::"memory");SBAR();
    #define PK(k) (bf16x8){lo[k][0],lo[k][1],lo[k][2],lo[k][3],hi[k][0],hi[k][1],hi[k][2],hi[k][3]}
    o[d0]=__builtin_amdgcn_mfma_f32_32x32x16_bf16(pa0,PK(0),o[d0],0,0,0);
    o[d0]=__builtin_amdgcn_mfma_f32_32x32x16_bf16(pa1,PK(1),o[d0],0,0,0);
    o[d0]=__builtin_amdgcn_mfma_f32_32x32x16_bf16(pa2,PK(2),o[d0],0,0,0);
    o[d0]=__builtin_amdgcn_mfma_f32_32x32x16_bf16(pa3,PK(3),o[d0],0,0,0);
    #undef PK
  }
}

#ifndef ATTN_STORE16
#define ATTN_STORE16(p,v) (*(u32x4*)(p)=(v))
#endif
struct AttnArgs { const bf16* Q; const bf16* K; const bf16* V; bf16* O; const float* cs; int qp, kp, op, q0; float bound; };
template<int THRL,bool FOX> __device__ __forceinline__ void attn_unit(const AttnArgs&A,char*shm){
  int tid_=threadIdx.x; asm volatile("":"+v"(tid_));
  const int tid=tid_,lane=tid&63,r32=lane&31,hi=lane>>5; const int wid=__builtin_amdgcn_readfirstlane(tid>>6);
  const int q0=A.q0; const long qp=A.qp,kp=A.kp,op=A.op;
  const bf16*Qw=A.Q+(long)(wid*QBLK)*qp;
  const bf16*Kh=A.K,*Vh=A.V;
  const unsigned lds0=(unsigned)(uintptr_t)shm;
  float*wsf=(float*)(shm+LDS_WS)+wid*64;
  const bf16*ksrc=Kh+(long)lane*kp+wid*8;
  const bf16*vsrc=Vh+(long)(16*(wid&3)+(lane>>2))*kp+(wid>>2)*32+(lane&3)*8;
  const unsigned kdst=lds0+LDS_K+wid*1024, vdst=lds0+LDS_V+wid*1024;
  #define TILE(s) (FOX ? (((s)<4) ? NT-4+(s) : NT-1-(s)) : (s))
  #define DMA_K(t,slot) glds16(ksrc+(long)TILE(t)*KVBLK*kp,(unsigned)__builtin_amdgcn_readfirstlane(kdst+(slot)))
  #define DMA_V(t,slot) glds16(vsrc+(long)TILE(t)*KVBLK*kp,(unsigned)__builtin_amdgcn_readfirstlane(vdst+(slot)))
  const int vb0=(int)(lds0+LDS_V)+((lane>>4)&1)*32+(lane&3)*8+(4*hi+((lane&15)>>2))*64;
  const char*Kbase=shm+LDS_K; bf16x8 kf[8];
  const lds_cptr shm3=(lds_cptr)shm; const lds_cptr kp0=shm3+LDS_K+hi*1024+r32*16; const lds_cptr vp0=shm3+LDS_V+((lane>>4)&1)*32+(lane&3)*8+(4*hi+((lane&15)>>2))*64;
  const int NT=FOX?(q0+QB)/KVBLK:4;
  float c2q=0.f;
  if(FOX){
    const int n=q0+QB; float*cl=(float*)(shm+LDS_CS);
    for(int i=tid;i<n;i+=NW*64)cl[i]=A.cs[i];
    c2q=A.cs[q0+wid*QBLK+r32]; }
  int NTL=NT;
  if(FOX){ const int a=lane; const bool in=(a<=NT-5); const float bias=in?(A.cs[q0]-A.cs[64*a+63]):0.f;
    const unsigned long long m=__ballot(in&&(2.f*A.bound+bias>=-40.f)); int cnt=__builtin_popcountll(m); cnt+=cnt&1; NTL=4+cnt; if(NTL>NT)NTL=NT; }
  DMA_K(0,0);DMA_V(0,0);DMA_K(1,SLOTB);
  bf16x8 qr[4];
  #pragma unroll
  for(int d0=0;d0<4;++d0)qr[d0]=*reinterpret_cast<const bf16x8*>(&Qw[(long)r32*qp+d0*16+hi*8]);
  float mhat=0.f,l_reg=0.f;f32x16 o[2];o[0]=f32x16{};o[1]=f32x16{};f32x16 negm=f32x16{};asm volatile("":"+v"(negm));
  const int qrel=wid*QBLK+r32;
  #define CMASK(P0,P1,t) do{ if(FOX){ if((t)<4)cmask(P0,P1,(t),qrel,hi); } }while(0)
  float cqm=c2q;
  bool resc=false;
  #define START(P0,P1) do{ const float rm=rowmax(P0,P1); resc=false; \
    { const float dl=rm; mhat=fadd_s(mhat,dl); \
      _Pragma("unroll") for(int r=0;r<16;++r){P0[r]=fsub_s(P0[r],dl);P1[r]=fsub_s(P1[r],dl);} \
      if(FOX){cqm=c2q-mhat;}else{ _Pragma("unroll") for(int r=0;r<16;++r)negm[r]=-mhat; asm volatile("":"+v"(negm)); } } \
    _Pragma("unroll") for(int r=0;r<16;++r)P0[r]=__builtin_amdgcn_exp2f(P0[r]); }while(0)
  #define RESC() do{ if(resc){ asm volatile("s_waitcnt lgkmcnt(0)":::"memory"); \
      _Pragma("unroll") for(int d_=0;d_<2;++d_) _Pragma("unroll") for(int r=0;r<16;++r)o[d_][r]*=wsf[crow(r,hi)]; } }while(0)
  #define CSINIT(C0,C1,s) do{ const __attribute__((address_space(3))) f32x4_t* cp_=(const __attribute__((address_space(3))) f32x4_t*)(shm3+LDS_CS)+(16*TILE(s)+hi); \
    _Pragma("unroll") for(int g_=0;g_<4;++g_){ const f32x4_t a_=cp_[2*g_], b_=cp_[8+2*g_]; \
      C0[4*g_]=cqm-a_[0];C0[4*g_+1]=cqm-a_[1];C0[4*g_+2]=cqm-a_[2];C0[4*g_+3]=cqm-a_[3]; C1[4*g_]=cqm-b_[0];C1[4*g_+1]=cqm-b_[1];C1[4*g_+2]=cqm-b_[2];C1[4*g_+3]=cqm-b_[3]; } }while(0)
  f32x16 pA0,pA1,pB0,pB1;
  int sl_prev=0,sl_cur=0,sl_next=SLOTB;
  #define ROT() do{sl_prev=sl_cur;sl_cur=sl_next;sl_next=(sl_next==(NSLOT-1)*SLOTB)?0:sl_next+SLOTB;}while(0)
  DMA_K(2,2*SLOTB);
  WAIT_BAR(3);
  if(FOX){ f32x16 ci0,ci1; CSINIT(ci0,ci1,0); qkt(pA0,pA1,Kbase,qr,ci0,ci1,r32,hi); } else qkt(pA0,pA1,Kbase,qr,negm,negm,r32,hi);
  asm volatile("s_nop 15\n\ts_nop 7":"+v"(pA0),"+v"(pA1));CMASK(pA0,pA1,0);
  START(pA0,pA1);
  _Pragma("unroll") for(int r=0;r<16;++r)pA1[r]=__builtin_amdgcn_exp2f(pA1[r]);
  WAIT_BAR(0);
  DMA_K(3,0);DMA_V(1,SLOTB);
  ROT();
  kload8(kf,kp0+sl_cur);
  WAIT_BAR(2);
  s16x4 vlo[8],vhi[8]; u32x4 pw0,pw1,pw2,pw3;
  #define PKW(P,B) cvtpk_s(P[B],P[B+1])
  #define PAF(k) __builtin_bit_cast(bf16x8,pw##k)
  #define VFR(i) (bf16x8){vlo[i][0],vlo[i][1],vlo[i][2],vlo[i][3],vhi[i][0],vhi[i][1],vhi[i][2],vhi[i][3]}
  #define PIN(x) asm volatile("":"+v"(x))
  #define MX3(a,b,c) __builtin_fmaxf(__builtin_fmaxf((a),(b)),(c))
  #define GAPA(MF,A0,A1,A2,A3,W0,W1,PW) do{ MF; sacc+=A0; sacc+=A1; sacc+=A2; sacc+=A3; PIN(sacc); W0; W1; PIN(PW); SBAR(); }while(0)
  #define EX(v) __builtin_amdgcn_exp2f(v)
  #define GAPB(MF,X,B) do{ MF; X[B]=EX(X[B]); X[B+1]=EX(X[B+1]); X[B+2]=EX(X[B+2]); X[B+3]=EX(X[B+3]); PIN(X); SBAR(); }while(0)
  #define VRD(i) do{ vlo[i]=vtr(vp_+(((i)>>2)*4096+((i)&3)*1024)); vhi[i]=vtr(vp_+(((i)>>2)*4096+((i)&3)*1024+512)); }while(0)
  #define KRD(G,j) do{ if(G){ kload2(kf,kp0+sl_next,j); SBAR(); } }while(0)
  #define STEP(C0,C1,P0,P1,t,GK,GV,GL) do{ SBAR(); \
    if(FOX){ CSINIT(C0,C1,t); SBAR(); } \
    const lds_cptr vp_=vp0+sl_prev; \
    VRD(0); SBAR(); float sacc=(P0[0]+P0[1]); \
    GAPA(C0=__builtin_amdgcn_mfma_f32_32x32x16_bf16(kf[0],qr[0],FOX?C0:negm,0,0,0), P0[2],P0[3],P0[4],P0[5],     pw0[0]=PKW(P0,0), pw0[1]=PKW(P0,2), pw0); \
    VRD(4); SBAR(); GAPA(C1=__builtin_amdgcn_mfma_f32_32x32x16_bf16(kf[1],qr[0],FOX?C1:negm,0,0,0), P0[6],P0[7],P0[8],P0[9],     pw0[2]=PKW(P0,4), pw0[3]=PKW(P0,6), pw0); \
    VRD(1); SBAR(); GAPA(C0=__builtin_amdgcn_mfma_f32_32x32x16_bf16(kf[2],qr[1],C0,0,0,0),   P0[10],P0[11],P0[12],P0[13], pw1[0]=PKW(P0,8), pw1[1]=PKW(P0,10), pw1); \
    VRD(5); SBAR(); GAPA(C1=__builtin_amdgcn_mfma_f32_32x32x16_bf16(kf[3],qr[1],C1,0,0,0),   P0[14],P0[15],P1[0],P1[1],   pw1[2]=PKW(P0,12),pw1[3]=PKW(P0,14), pw1); \
    VRD(2); SBAR(); GAPA(C0=__builtin_amdgcn_mfma_f32_32x32x16_bf16(kf[4],qr[2],C0,0,0,0),   P1[2],P1[3],P1[4],P1[5],     pw2[0]=PKW(P1,0), pw2[1]=PKW(P1,2), pw2); \
    VRD(6); SBAR(); GAPA(C1=__builtin_amdgcn_mfma_f32_32x32x16_bf16(kf[5],qr[2],C1,0,0,0),   P1[6],P1[7],P1[8],P1[9],     pw2[2]=PKW(P1,4), pw2[3]=PKW(P1,6), pw2); \
    VRD(3); SBAR(); GAPA(C0=__builtin_amdgcn_mfma_f32_32x32x16_bf16(kf[6],qr[3],C0,0,0,0),   P1[10],P1[11],P1[12],P1[13], pw3[0]=PKW(P1,8), pw3[1]=PKW(P1,10), pw3); \
    VRD(7); SBAR(); GAPA(C1=__builtin_amdgcn_mfma_f32_32x32x16_bf16(kf[7],qr[3],C1,0,0,0),   P1[14],P1[15],0.f,0.f,       pw3[2]=PKW(P1,12),pw3[3]=PKW(P1,14), pw3); \
    l_reg+=sacc; \
    if(GK){DMA_K((t)+3,sl_cur);} if(GV){DMA_V((t)+1,sl_next);} \
    CMASK(C0,C1,t); \
    { float a=MX3(C0[0],C0[1],C1[0]),b=MX3(C0[2],C0[3],C1[1]); a=MX3(a,C1[2],C1[3]); \
      _Pragma("unroll") for(int r=4;r<16;r+=4){a=MX3(a,C0[r],C0[r+1]);b=MX3(b,C0[r+2],C0[r+3]);a=MX3(a,C1[r],C1[r+1]);b=MX3(b,C1[r+2],C1[r+3]);} \
      float rm=__builtin_fmaxf(a,b); { auto rr=__builtin_amdgcn_permlane32_swap(__float_as_uint(rm),__float_as_uint(rm),false,false); rm=__builtin_fmaxf(__uint_as_float(rr[0]),__uint_as_float(rr[1])); } \
      resc=false; \
      if(__builtin_expect(__any(rm>(float)THRL),0)){ const float dl=__builtin_fmaxf(rm,0.f); mhat+=dl; \
        _Pragma("unroll") for(int r=0;r<16;++r){C0[r]-=dl;C1[r]-=dl;} \
        if(FOX){cqm-=dl;}else{ _Pragma("unroll") for(int r=0;r<16;++r)negm[r]=-mhat; asm volatile("":"+v"(negm)); } \
        const float f=__builtin_amdgcn_exp2f(-dl); l_reg*=f; if(hi==0)wsf[r32]=f; resc=true; } } \
    SBAR(); \
    GAPB(o[0]=__builtin_amdgcn_mfma_f32_32x32x16_bf16(PAF(0),VFR(0),o[0],0,0,0), C0,0); \
    GAPB(o[1]=__builtin_amdgcn_mfma_f32_32x32x16_bf16(PAF(0),VFR(4),o[1],0,0,0), C0,4); \
    KRD(GL,0); GAPB(o[0]=__builtin_amdgcn_mfma_f32_32x32x16_bf16(PAF(1),VFR(1),o[0],0,0,0), C0,8); \
    KRD(GL,1); GAPB(o[1]=__builtin_amdgcn_mfma_f32_32x32x16_bf16(PAF(1),VFR(5),o[1],0,0,0), C0,12); \
    KRD(GL,2); GAPB(o[0]=__builtin_amdgcn_mfma_f32_32x32x16_bf16(PAF(2),VFR(2),o[0],0,0,0), C1,0); \
    KRD(GL,3); GAPB(o[1]=__builtin_amdgcn_mfma_f32_32x32x16_bf16(PAF(2),VFR(6),o[1],0,0,0), C1,4); \
    GAPB(o[0]=__builtin_amdgcn_mfma_f32_32x32x16_bf16(PAF(3),VFR(3),o[0],0,0,0), C1,8); \
    GAPB(o[1]=__builtin_amdgcn_mfma_f32_32x32x16_bf16(PAF(3),VFR(7),o[1],0,0,0), C1,12); \
    }while(0)
  int t=1;
  if(FOX){ for(;t<5&&t+5<NTL;t+=2){
    STEP(pB0,pB1,pA0,pA1,t,true,true,true);     WAIT_BAR(2); RESC(); ROT();
    STEP(pA0,pA1,pB0,pB1,t+1,true,true,true);   WAIT_BAR(2); RESC(); ROT();
  } }
  #undef CMASK
  #define CMASK(P0,P1,t) do{}while(0)
  for(;t+5<NTL;t+=2){
    STEP(pB0,pB1,pA0,pA1,t,true,true,true);     WAIT_BAR(2); RESC(); ROT();
    STEP(pA0,pA1,pB0,pB1,t+1,true,true,true);   WAIT_BAR(2); RESC(); ROT();
  }
  #undef CMASK
  #define CMASK(P0,P1,t) do{ if(FOX){ if((t)<4)cmask(P0,P1,(t),qrel,hi); } }while(0)
  #define ENDW(tt) do{ if((tt)+3<NTL){WAIT_BAR(2);} else if((tt)+2<NTL){WAIT_BAR(1);} else {WAIT_BAR(0);} }while(0)
  for(;t+1<NTL;t+=2){
    STEP(pB0,pB1,pA0,pA1,t,(t+3<NTL),(t+1<NTL),(t+1<NTL));       ENDW(t);   RESC(); ROT();
    STEP(pA0,pA1,pB0,pB1,t+1,(t+4<NTL),(t+2<NTL),(t+2<NTL));     ENDW(t+1); RESC(); ROT();
  }
  STEP(pB0,pB1,pA0,pA1,NTL-1,false,false,false); RESC();
  { float sacc=pB0[0]+pB0[1]; _Pragma("unroll") for(int r=2;r<16;++r)sacc+=pB0[r]; _Pragma("unroll") for(int r=0;r<16;++r)sacc+=pB1[r]; l_reg+=sacc;
    pw0=(u32x4){PKW(pB0,0),PKW(pB0,2),PKW(pB0,4),PKW(pB0,6)};pw1=(u32x4){PKW(pB0,8),PKW(pB0,10),PKW(pB0,12),PKW(pB0,14)};pw2=(u32x4){PKW(pB1,0),PKW(pB1,2),PKW(pB1,4),PKW(pB1,6)};pw3=(u32x4){PKW(pB1,8),PKW(pB1,10),PKW(pB1,12),PKW(pB1,14)};
    SBAR(); pv(o,vb0+sl_cur,PAF(0),PAF(1),PAF(2),PAF(3)); }
  #undef PKW
  #undef PAF
  #undef VFR
  #undef PIN
  #undef MX3
  #undef GAPA
  #undef GAPB
  #undef EX
  #undef VRD
  #undef KRD
  #undef STEP
  #undef ENDW
  {auto rr=__builtin_amdgcn_permlane32_swap(__float_as_uint(l_reg),__float_as_uint(l_reg),false,false);l_reg=__uint_as_float(rr[0])+__uint_as_float(rr[1]);}
  if(hi==0)wsf[32+r32]=l_reg;asm volatile("s_waitcnt lgkmcnt(0)":::"memory");
  float rli[16];
  #pragma unroll
  for(int r=0;r<16;++r)rli[r]=__builtin_amdgcn_rcpf(wsf[32+crow(r,hi)]);
  bf16*Ow=A.O+(long)(wid*QBLK)*op;
  { bf16*stg=(bf16*)(shm+LDS_OST)+wid*2048;
    #pragma unroll
    for(int r=0;r<16;++r){const int orow=crow(r,hi);
      #pragma unroll
      for(int d0=0;d0<2;++d0)stg[orow*64+d0*32+r32]=__float2bfloat16(o[d0][r]*rli[r]);}
    asm volatile("s_waitcnt lgkmcnt(0)":::"memory");
    #pragma unroll
    for(int i=0;i<4;++i){const int row=i*8+(lane>>3),ch=lane&7; const u32x4 v=*(const u32x4*)(stg+row*64+ch*8); ATTN_STORE16(Ow+(long)row*op+ch*8,v);} }
  asm volatile("s_waitcnt lgkmcnt(0)\n\ts_barrier":::"memory");
  #undef DMA_K
  #undef DMA_V
  #undef TILE
  #undef CSINIT
  #undef CMASK
  #undef START
  #undef RESC
  #undef ROT
}
constexpr int ATTN_LDS_BYTES=LDS_BYTES;
#undef SBAR
#undef WAIT_BAR
}


constexpr size_t MiB = 1u << 20;
constexpr size_t WS_CTL = 0, CTL_ZERO_BYTES = 1 * MiB;
constexpr size_t WS_WINA = 2 * MiB;
constexpr size_t WS_WINB = 12 * MiB;
constexpr size_t WS_WOUT = 16 * MiB;
constexpr size_t WS_WMKV = 24 * MiB;
constexpr size_t WS_WKV = 28 * MiB;
constexpr size_t WS_WPQ = 32 * MiB;
constexpr size_t WS_PKEYS = 48 * MiB;
constexpr size_t WS_MN = 50 * MiB;
constexpr size_t WS_MKV = 66 * MiB;
constexpr size_t WS_LOGF = 74 * MiB;
constexpr size_t WS_C2 = 76 * MiB;
constexpr size_t WS_X = 80 * MiB;
constexpr size_t WS_Z = 208 * MiB;
constexpr size_t WS_PQ = 368 * MiB;
constexpr size_t WS_KV = 496 * MiB;
constexpr size_t WS_YCAT = 592 * MiB;
constexpr size_t WS_IDX = 656 * MiB;
constexpr size_t WS_GATE = 672 * MiB;
constexpr size_t WS_U8 = 688 * MiB;
constexpr size_t WS_V8 = 752 * MiB;
constexpr size_t WS_SU = 816 * MiB;
constexpr size_t WS_SV = 817 * MiB;
constexpr size_t WS_SX = 818 * MiB;
constexpr size_t WS_WSUM = 819 * MiB;
constexpr size_t WS_XQ = 820 * MiB;
constexpr size_t WS_W = 852 * MiB;
constexpr size_t WS_PA = 868 * MiB;
constexpr size_t WS_SSQA = 996 * MiB;
constexpr size_t WS_SSQB = 998 * MiB;
constexpr size_t WS_END = 1000 * MiB;
constexpr int CW_TMO = 0, CW_CODE = 1, CW_BAR = 4096, CW_QM2 = 8192  , CW_KM2 = 8192 + 256  ;

constexpr int PH_PRO = 0, PH_MEMKV = 1, PH_L0 = 2, PH_PER_LAYER = 10, PH_END = PH_L0 + 4 * PH_PER_LAYER;
constexpr int NWAVES = 8;
constexpr int RING_OFF = 0, RING_BYTES = 155648  , LDSCTL_OFF = RING_BYTES, MISC_OFF = LDSCTL_OFF + 320, LDS_BYTES = 156672;


typedef __bf16 bf16x2v __attribute__((ext_vector_type(2)));
__device__ __forceinline__ float dot2bf(unsigned a, unsigned b, float c) { return __builtin_amdgcn_fdot2_f32_bf16(__builtin_bit_cast(bf16x2v, a), __builtin_bit_cast(bf16x2v, b), c, false); }

template <int R> __device__ __forceinline__ void quant_table_rows(const float* const (&src)[R], unsigned char* const (&dst)[R], float* const (&sco)[R], const bool (&ok)[R], int lane);
template <int R> __device__ __forceinline__ void quant_u4_rows(const float* const (&src)[R], unsigned char* const (&dst)[R], float* const (&sco)[R], const bool (&ok)[R], int lane);
__device__ __forceinline__ void tr_item(const float* W, int K, int N, int Npad, bf16* WT, LAS float* scr, int item, int lane, const float* gk = nullptr) {
    const int nblk = Npad / 32, kb = item / nblk, nb = item % nblk, k0 = 64 * kb, n0 = 32 * nb;
    const int nn = n0 + (lane & 31); const bool ok = nn < N;
#pragma unroll 8
    for (int i = 0; i < 32; ++i) { const int kk = 2 * i + (lane >> 5); scr[kk * 33 + (lane & 31)] = ok ? W[(size_t)(k0 + kk) * N + nn] * (gk ? gk[k0 + kk] : 1.f) : 0.f; }
    LDS_WAIT(); asm volatile("" ::: "memory");
    const int c = lane & 7;
#pragma unroll
    for (int j = 0; j < 4; ++j) { const int n = (lane >> 3) + 8 * j; const LAS float* s = scr + (8 * c) * 33 + n;
        v4u o; o.x = pk2(s[0 * 33], s[1 * 33]); o.y = pk2(s[2 * 33], s[3 * 33]); o.z = pk2(s[4 * 33], s[5 * 33]); o.w = pk2(s[6 * 33], s[7 * 33]);
        *(GAS v4u*)(WT + (size_t)(n0 + n) * K + k0 + 8 * c) = o; }
    LDS_WAIT(); asm volatile("" ::: "memory");
}
__device__ __forceinline__ void norm_row(const float* xrow, const float* g1, bf16* o1, const float* g2, bf16* o2, int lane) {
    const f32x4* xr = (const f32x4*)xrow + lane; f32x4 v[4]; float s = 0.f;
#pragma unroll
    for (int j = 0; j < 4; ++j) { v[j] = xr[64 * j]; s += (v[j].x * v[j].x + v[j].y * v[j].y) + (v[j].z * v[j].z + v[j].w * v[j].w); }
    const float rstd = 1.0f / sqrtf(wave_sum(s) * (1.f / D) + EPS);
#pragma unroll
    for (int j = 0; j < 4; ++j) { const f32x4 g = ((const f32x4*)g1)[64 * j + lane]; const f32x4 y = v[j] * rstd * g;
        u32x2 w; w.x = pk2(y.x, y.y); w.y = pk2(y.z, y.w); ((u32x2*)o1)[64 * j + lane] = w;
        if (o2) { const f32x4 gg = ((const f32x4*)g2)[64 * j + lane]; const f32x4 y2 = v[j] * rstd * gg; u32x2 w2; w2.x = pk2(y2.x, y2.y); w2.y = pk2(y2.z, y2.w); ((u32x2*)o2)[64 * j + lane] = w2; } }
}
__device__ __forceinline__ void cvt_range(const float* src, bf16* dst, size_t n8, size_t gt, size_t ngt) {
    for (size_t i = gt; i < n8; i += ngt) { const f32x4 a = ((const f32x4*)src)[2 * i], b = ((const f32x4*)src)[2 * i + 1];
        u32x4 o; o.x = pk2(a.x, a.y); o.y = pk2(a.z, a.w); o.z = pk2(b.x, b.y); o.w = pk2(b.z, b.w); ((u32x4*)dst)[i] = o; }
}

__device__ __forceinline__ void phase_prologue(const float* const* in, unsigned char* w, LAS unsigned char* ldsp, int tid, int lane, int wave, int G) {
    LAS float* scr = (LAS float*)(ldsp + wave * 16384);
    const int gw = blockIdx.x * NWAVES + wave, NGW = G * NWAVES;
    constexpr int I_INA = (D / 64) * (NA / 32), I_INB = (D / 64) * (NB / 32), I_OUT = (D / 64) * (D / 32), I_MKV = (D / 64) * (512 / 32), I_KV = (D / 64) * (NKVP / 32), I_PQ = (D / 64) * (NPQ / 32);
    constexpr int NITEMS = 2 * I_INA + 2 * I_INB + 4 * I_OUT + 4 * I_MKV + I_KV + 4 * I_PQ;
    for (int it = gw; it < NITEMS; it += NGW) {
        int r = it;
        if (r < 2 * I_INA) { const int l = r / I_INA; tr_item(in[3] + (size_t)l * D * NA, D, NA, NA, (bf16*)(w + WS_WINA) + (size_t)l * NA * D, scr, r % I_INA, lane, in[2] + (size_t)l * D); continue; } r -= 2 * I_INA;
        if (r < 2 * I_INB) { const int l = r / I_INB; tr_item(in[5] + (size_t)l * D * NB, D, NB, NB, (bf16*)(w + WS_WINB) + (size_t)l * NB * D, scr, r % I_INB, lane, in[2] + (size_t)(l + 2) * D); continue; } r -= 2 * I_INB;
        if (r < 4 * I_OUT) { const int l = r / I_OUT; tr_item(in[6] + (size_t)l * D * D, D, D, D, (bf16*)(w + WS_WOUT) + (size_t)l * D * D, scr, r % I_OUT, lane); continue; } r -= 4 * I_OUT;
        if (r < 4 * I_MKV) { const int l = r / I_MKV; tr_item(in[8] + (size_t)l * D * 512, D, 512, 512, (bf16*)(w + WS_WMKV) + (size_t)l * 512 * D, scr, r % I_MKV, lane); continue; } r -= 4 * I_MKV;
        if (r < I_KV) { tr_item(in[10], D, NKV, NKVP, (bf16*)(w + WS_WKV), scr, r, lane, in[9]); continue; } r -= I_KV;
        { const int l = r / I_PQ; tr_item(in[13] + (size_t)l * D * NPQ, D, NPQ, NPQ, (bf16*)(w + WS_WPQ) + (size_t)l * NPQ * D, scr, r % I_PQ, lane, in[12] + (size_t)l * D); }
    }
    const size_t gt = (size_t)blockIdx.x * (NWAVES * 64) + tid, ngt = (size_t)G * NWAVES * 64;
    cvt_range(in[14], (bf16*)(w + WS_PKEYS), (size_t)4 * 8 * 2 * 128 * 128 / 8, gt, ngt);
    for (int r = gw; r < 4 * 2048; r += NGW) { const int l = r >> 11, m = r & 2047; norm_row(in[1] + (size_t)m * D, in[7] + l * D, (bf16*)(w + WS_MN) + (size_t)r * D, nullptr, nullptr, lane); }
    for (int rb = gw; rb < T; rb += 2 * NGW) { f32x4 v[2][4];
#pragma unroll
        for (int u = 0; u < 2; ++u) { const int r = (rb + u * NGW < T) ? rb + u * NGW : rb; const f32x4* xr = (const f32x4*)(in[0] + (size_t)r * D) + lane;
#pragma unroll
            for (int j = 0; j < 4; ++j) v[u][j] = xr[64 * j]; }
#pragma unroll
        for (int u = 0; u < 2; ++u) { const int r = rb + u * NGW; if (r >= T) continue; float s = 0.f;
#pragma unroll
            for (int j = 0; j < 4; ++j) { s += (v[u][j].x * v[u][j].x + v[u][j].y * v[u][j].y) + (v[u][j].z * v[u][j].z + v[u][j].w * v[u][j].w);
                u32x2 o; o.x = pk2(v[u][j].x, v[u][j].y); o.y = pk2(v[u][j].z, v[u][j].w); ((u32x2*)((bf16*)(w + WS_X) + (size_t)r * D))[64 * j + lane] = o; }
            s = wave_sum(s);
            if (lane < 8) ((float*)(w + WS_SSQB))[(size_t)r * 16 + lane] = (lane == 0) ? s : 0.f; } }
}
__device__ __forceinline__ void phase_norm(const float* x, const float* g, bf16* o, int lane, int wave, int G) {
    const int gw = blockIdx.x * NWAVES + wave, NGW = G * NWAVES;
    for (int r = gw; r < T; r += NGW) norm_row(x + (size_t)r * D, g, o + (size_t)r * D, nullptr, nullptr, lane);
}
__device__ __forceinline__ void phase_conv(const bf16* Z, const float* cw, bf16* Y, int tid, int G) {
    const int nthr = G * NWAVES * 64;
    for (int item = blockIdx.x * (NWAVES * 64) + tid; item < (T / 16) * 96; item += nthr) {
        const int cg8 = item % 96, strip = item / 96; const int t0 = strip * 16, c0 = cg8 * 8;
        float w0[8], w1[8], w2[8], p2[8], p1[8];
#pragma unroll
        for (int i = 0; i < 8; ++i) { w0[i] = cw[c0 + i]; w1[i] = cw[768 + c0 + i]; w2[i] = cw[1536 + c0 + i]; p2[i] = 0.f; p1[i] = 0.f; }
        auto prod = [&](int row, float* p) {
            const u32x4 u = *(const u32x4*)(Z + (size_t)row * NA + c0), c = *(const u32x4*)(Z + (size_t)row * NA + 768 + c0);
            p[0] = bflo(u.x) * bflo(c.x); p[1] = bfhi(u.x) * bfhi(c.x); p[2] = bflo(u.y) * bflo(c.y); p[3] = bfhi(u.y) * bfhi(c.y);
            p[4] = bflo(u.z) * bflo(c.z); p[5] = bfhi(u.z) * bfhi(c.z); p[6] = bflo(u.w) * bflo(c.w); p[7] = bfhi(u.w) * bfhi(c.w);
        };
        if ((t0 % SEQ) != 0) { prod(t0 - 2, p2); prod(t0 - 1, p1); }
#pragma unroll 4
        for (int i = 0; i < 16; ++i) {
            const int row = t0 + i; float p0[8]; prod(row, p0);
            const u32x4 bg = *(const u32x4*)(Z + (size_t)row * NA + 1536 + c0);
            const float bb[8] = {bflo(bg.x), bfhi(bg.x), bflo(bg.y), bfhi(bg.y), bflo(bg.z), bfhi(bg.z), bflo(bg.w), bfhi(bg.w)};
            float y[8];
#pragma unroll
            for (int q = 0; q < 8; ++q) { y[q] = bb[q] * (w0[q] * p2[q] + w1[q] * p1[q] + w2[q] * p0[q]); p2[q] = p1[q]; p1[q] = p0[q]; }
            u32x4 o; o.x = pk2(y[0], y[1]); o.y = pk2(y[2], y[3]); o.z = pk2(y[4], y[5]); o.w = pk2(y[6], y[7]);
            *(u32x4*)(Y + (size_t)row * D + c0) = o;
        }
    }
}
__device__ __forceinline__ void phase_cumsum(const float* logf, float* c2, int lane, int wave, int G) {
    const int gw = blockIdx.x * NWAVES + wave, NGW = G * NWAVES;
    for (int bh = gw; bh < BATCH * FOXH; bh += NGW) {
        const float* src = logf + (size_t)bh * SEQ + lane * 64; float* dst = c2 + (size_t)bh * SEQ + lane * 64;
        f32x4 v[16]; float s = 0.f;
#pragma unroll
        for (int i = 0; i < 16; ++i) v[i] = ((const f32x4*)src)[i];
#pragma unroll
        for (int i = 0; i < 16; ++i) s += (v[i].x + v[i].y) + (v[i].z + v[i].w);
        float incl = s;
#pragma unroll
        for (int o = 1; o < 64; o <<= 1) { const float t = __shfl_up(incl, o); if (lane >= o) incl += t; }
        float run = incl - s;
#pragma unroll
        for (int i = 0; i < 16; ++i) { f32x4 o; run += v[i].x; o.x = run * LOG2E; run += v[i].y; o.y = run * LOG2E; run += v[i].z; o.z = run * LOG2E; run += v[i].w; o.w = run * LOG2E; ((f32x4*)dst)[i] = o; }
    }
}

__device__ __forceinline__ void quant_table_item(const float* const* in, unsigned char* w, int l, int rb, int NGW, int lane) {
    constexpr int R = 4;
    const float* src[R]; unsigned char* dst[R]; float* sco[R]; bool ok[R];
#pragma unroll
    for (int u = 0; u < R; ++u) { int r = rb + u * NGW; ok[u] = r < 2 * NEXP; if (!ok[u]) r = rb; const int tab = r >> 14, e = r & (NEXP - 1);
        src[u] = in[15 + tab] + ((size_t)l * NEXP + e) * D; dst[u] = (unsigned char*)(w + (tab ? WS_V8 : WS_U8)) + ((size_t)l * 4 * NEXP + e) * 128; sco[u] = (float*)(w + (tab ? WS_SV : WS_SU)) + l * NEXP + e; }
    quant_u4_rows<R>(src, dst, sco, ok, lane);
}


namespace route {
__device__ __forceinline__ int kmax(int a, int b) { int r; asm("v_max_f32 %0, %1, %2" : "=v"(r) : "v"(a), "v"(b)); return r; }
__device__ __forceinline__ int kmin(int a, int b) { int r; asm("v_min_f32 %0, %1, %2" : "=v"(r) : "v"(a), "v"(b)); return r; }
__device__ __forceinline__ void ce(int& a, int& b) { const int mx = kmax(a, b), mn = kmin(a, b); a = mx; b = mn; }
template <int N> __device__ __forceinline__ void clean_desc(int (&v)[N]) {
#pragma unroll
    for (int j = N >> 1; j > 0; j >>= 1)
#pragma unroll
        for (int i = 0; i < N; ++i) { const int l = i ^ j; if (l > i) ce(v[i], v[l]); }
}
template <int N> __device__ __forceinline__ void sort_desc(int (&v)[N]) {
#pragma unroll
    for (int k = 2; k <= N; k <<= 1)
#pragma unroll
        for (int j = k >> 1; j > 0; j >>= 1)
#pragma unroll
            for (int i = 0; i < N; ++i) { const int l = i ^ j; if (l > i) { if ((i & k) == 0) ce(v[i], v[l]); else ce(v[l], v[i]); } }
}
__device__ __forceinline__ void sort16(int (&v)[16]) {
    ce(v[0], v[13]); ce(v[1], v[12]); ce(v[2], v[15]); ce(v[3], v[14]); ce(v[4], v[8]); ce(v[5], v[6]); ce(v[7], v[11]); ce(v[9], v[10]); ce(v[0], v[5]); ce(v[1], v[7]); ce(v[2], v[9]); ce(v[3], v[4]); ce(v[6], v[13]); ce(v[8], v[14]); ce(v[10], v[15]); ce(v[11], v[12]); ce(v[0], v[1]); ce(v[2], v[3]); ce(v[4], v[5]); ce(v[6], v[8]); ce(v[7], v[9]); ce(v[10], v[11]); ce(v[12], v[13]); ce(v[14], v[15]); ce(v[0], v[2]); ce(v[1], v[3]); ce(v[4], v[10]); ce(v[5], v[11]); ce(v[6], v[7]); ce(v[8], v[9]); ce(v[12], v[14]); ce(v[13], v[15]); ce(v[1], v[2]); ce(v[3], v[12]); ce(v[4], v[6]); ce(v[5], v[7]); ce(v[8], v[10]); ce(v[9], v[11]); ce(v[13], v[14]); ce(v[1], v[4]); ce(v[2], v[6]); ce(v[5], v[8]); ce(v[7], v[10]); ce(v[9], v[13]); ce(v[11], v[14]); ce(v[2], v[4]); ce(v[3], v[6]); ce(v[9], v[12]); ce(v[11], v[13]); ce(v[3], v[5]); ce(v[6], v[8]); ce(v[7], v[9]); ce(v[10], v[12]); ce(v[3], v[4]); ce(v[5], v[6]); ce(v[7], v[8]); ce(v[9], v[10]); ce(v[11], v[12]); ce(v[6], v[7]); ce(v[8], v[9]);
}
__device__ __forceinline__ void merge16(int (&a)[16], const int (&b)[16]) {
#pragma unroll
    for (int i = 0; i < 16; ++i) a[i] = kmax(a[i], b[15 - i]);
    clean_desc<16>(a);
}
constexpr int KROW = 272;
constexpr int LDS_KEYS = 0, LDS_TAB = 256 * KROW;
}
__device__ __forceinline__ void route_stage_keys(const bf16* KEYS  , LAS unsigned char* ldsp, int tid) {
    using namespace route;
    const bf16* ksrc = KEYS + (size_t)(blockIdx.x & 7) * 2 * 128 * 128;
    for (int c = tid; c < 256 * 16; c += NWAVES * 64) { const int row = c >> 4, ch = c & 15; const u32x4 v = *(const u32x4*)(ksrc + row * 128 + ch * 8); *(LAS u32x4*)(ldsp + LDS_KEYS + row * KROW + ch * 16) = v; }
}
__device__ __forceinline__ void route_tile(const bf16* PQ, unsigned short* IDX, float* GATE, LAS unsigned char* ldsp, int tile, int lane, int wave) {
    using namespace route;
    const int h = blockIdx.x & 7;
    const int r32 = lane & 31, hi = lane >> 5;
    LAS unsigned char* tab = ldsp + LDS_TAB + wave * 1024;
    {
        const int t = tile * 32 + r32;
        const bf16* qrow = PQ + (size_t)t * NPQ + h * 256 + 8 * hi;
        bf16x8 qq[2][8];
#pragma unroll
        for (int p = 0; p < 2; ++p)
#pragma unroll
            for (int d0 = 0; d0 < 8; ++d0) qq[p][d0] = *(const bf16x8*)(qrow + p * 128 + 16 * d0);
        int P[2][16];
#pragma unroll
        for (int p = 0; p < 2; ++p) {
            f32x16 acc[4];
#pragma unroll
            for (int nb = 0; nb < 4; ++nb)
#pragma unroll
                for (int r = 0; r < 16; ++r) acc[nb][r] = 0.f;
            const LAS unsigned char* kb = ldsp + LDS_KEYS + (p * 128 + r32) * KROW + hi * 16;
#pragma unroll
            for (int d0 = 0; d0 < 8; ++d0)
#pragma unroll
                for (int nb = 0; nb < 4; ++nb) { const bf16x8 kf = *(const LAS bf16x8*)(kb + nb * 32 * KROW + d0 * 32); acc[nb] = __builtin_amdgcn_mfma_f32_32x32x16_bf16(kf, qq[p][d0], acc[nb], 0, 0, 0); }
            int k[4][16];
#pragma unroll
            for (int nb = 0; nb < 4; ++nb)
#pragma unroll
                for (int r = 0; r < 16; ++r) { const int cst = 127 - (32 * nb + (r & 3) + 8 * (r >> 2)); k[nb][r] = (__float_as_int(acc[nb][r]) & ~127) | cst; }
#pragma unroll
            for (int nb = 0; nb < 4; ++nb) sort16(k[nb]);
            merge16(k[0], k[1]); merge16(k[2], k[3]); merge16(k[0], k[2]);
#pragma unroll
            for (int i = 0; i < 16; ++i) P[p][i] = k[0][i] - 4 * hi;
        }
        int OWN[16], OTH[16];
#pragma unroll
        for (int i = 0; i < 16; ++i) { const auto rr = __builtin_amdgcn_permlane32_swap((unsigned)P[0][i], (unsigned)P[1][i], false, false); OWN[i] = (int)rr[0]; OTH[i] = (int)rr[1]; }
        merge16(OWN, OTH);
        { u32x4 tb;
#define TBW(q) (unsigned)((127 - (OWN[4 * q] & 127)) | ((127 - (OWN[4 * q + 1] & 127)) << 8) | ((127 - (OWN[4 * q + 2] & 127)) << 16) | ((127 - (OWN[4 * q + 3] & 127)) << 24))
          tb.x = TBW(0); tb.y = TBW(1); tb.z = TBW(2); tb.w = TBW(3);
#undef TBW
          *(LAS u32x4*)(tab + r32 * 32 + hi * 16) = tb; }
        asm volatile("" ::: "memory");
        float fo[16], ft[16];
#pragma unroll
        for (int i = 0; i < 16; ++i) { const auto rr = __builtin_amdgcn_permlane32_swap((unsigned)OWN[i], (unsigned)OWN[i], false, false); const int oth = hi ? (int)rr[0] : (int)rr[1];
            fo[i] = __int_as_float(OWN[i] & ~127); ft[i] = __int_as_float(oth & ~127); }
        int c[32];
#define CANDV(x, y) ((__float_as_int(fo[x] + ft[y]) & ~255) | (255 - (hi ? (((y) << 4) | (x)) : (((x) << 4) | (y)))))
        c[0] = CANDV(0, 1);
        c[1] = CANDV(0, 2);
        c[2] = CANDV(0, 3);
        c[3] = CANDV(0, 4);
        c[4] = CANDV(0, 5);
        c[5] = CANDV(0, 6);
        c[6] = CANDV(0, 7);
        c[7] = CANDV(0, 8);
        c[8] = CANDV(0, 9);
        c[9] = CANDV(0, 10);
        c[10] = CANDV(0, 11);
        c[11] = CANDV(0, 12);
        c[12] = CANDV(0, 13);
        c[13] = CANDV(0, 14);
        c[14] = CANDV(0, 15);
        c[15] = CANDV(1, 2);
        c[16] = CANDV(1, 3);
        c[17] = CANDV(1, 4);
        c[18] = CANDV(1, 5);
        c[19] = CANDV(1, 6);
        c[20] = CANDV(1, 7);
        c[21] = CANDV(2, 3);
        c[22] = CANDV(2, 4);
        c[23] = hi ? (int)0xFF800000 : CANDV(0, 0);
        c[24] = hi ? (int)0xFF800000 : CANDV(1, 1);
        c[25] = hi ? (int)0xFF800000 : CANDV(2, 2);
        c[26] = hi ? (int)0xFF800000 : CANDV(3, 3);
        c[27] = (int)0xFF800000;
        c[28] = (int)0xFF800000;
        c[29] = (int)0xFF800000;
        c[30] = (int)0xFF800000;
        c[31] = (int)0xFF800000;
#undef CANDV
        int ca[16], cb[16];
#pragma unroll
        for (int i = 0; i < 16; ++i) { ca[i] = c[i]; cb[i] = c[16 + i]; }
        sort16(ca); sort16(cb); merge16(ca, cb);
#pragma unroll
        for (int i = 0; i < 16; ++i) { const auto rr = __builtin_amdgcn_permlane32_swap((unsigned)ca[i], (unsigned)ca[i], false, false); cb[i] = hi ? (int)rr[0] : (int)rr[1]; }
        merge16(ca, cb);
        float ev[16]; float sum = 0.f; const float mx = __int_as_float(ca[0] & ~255);
#pragma unroll
        for (int i = 0; i < 16; ++i) { ev[i] = __expf(__int_as_float(ca[i] & ~255) - mx); sum += ev[i]; }
        const float inv = 1.0f / sum;
        int oi[8]; float og[8]; int him = -hi; asm volatile("" : "+v"(him));
#pragma unroll
        for (int j = 0; j < 8; ++j) { const int key = ca[j] ^ ((ca[j] ^ ca[8 + j]) & him); const float e = __int_as_float(__float_as_int(ev[j]) ^ ((__float_as_int(ev[j]) ^ __float_as_int(ev[8 + j])) & him)); const int code = 255 - (key & 255);
            const int n1 = *(const LAS unsigned char*)(tab + r32 * 32 + (code >> 4)), n2 = *(const LAS unsigned char*)(tab + r32 * 32 + 16 + (code & 15));
            oi[j] = n1 * 128 + n2; og[j] = e * inv; }
        float* gp = GATE + (size_t)t * 128 + h * 16 + 8 * hi;
        *(u32x4*)(IDX + (size_t)t * 128 + h * 16 + 8 * hi) = (u32x4){(unsigned)oi[0] | ((unsigned)oi[1] << 16), (unsigned)oi[2] | ((unsigned)oi[3] << 16), (unsigned)oi[4] | ((unsigned)oi[5] << 16), (unsigned)oi[6] | ((unsigned)oi[7] << 16)};
        *(f32x4*)gp = (f32x4){og[0], og[1], og[2], og[3]}; *(f32x4*)(gp + 4) = (f32x4){og[4], og[5], og[6], og[7]};
        asm volatile("s_waitcnt lgkmcnt(0)" ::: "memory");
    }
}


typedef int v4i __attribute__((ext_vector_type(4)));
typedef int v2i __attribute__((ext_vector_type(2)));
__device__ __forceinline__ v2i tr8_read(unsigned lds_addr) { v2i r; asm volatile("ds_read_b64_tr_b8 %0, %1\n\ts_waitcnt lgkmcnt(0)" : "=&v"(r) : "v"(lds_addr) : "memory"); return r; }
__device__ __forceinline__ unsigned selftest_layouts(LAS unsigned char* tile, int lane) {
    unsigned bad = 0;
    for (int i = lane; i < 16 * 16; i += 64) { const int r = i >> 4, c = i & 15; tile[r * 144 + c] = (unsigned char)((7 * r + 3 * c + 1) & 127); }
    asm volatile("s_waitcnt lgkmcnt(0)" ::: "memory");
    { const int m = lane & 15; const unsigned base = (unsigned)(size_t)tile + (m >> 1) * 144 + 8 * (m & 1);
      const v2i r0 = tr8_read(base), r1 = tr8_read(base + 8 * 144);
#pragma unroll
      for (int p = 0; p < 8; ++p) { const int w0 = (p < 4) ? r0[0] : r0[1], w1 = (p < 4) ? r1[0] : r1[1]; const int b0 = (w0 >> (8 * (p & 3))) & 255, b1 = (w1 >> (8 * (p & 3))) & 255;
          if (b0 != ((7 * p + 3 * m + 1) & 127)) bad |= 1u; if (b1 != ((7 * (p + 8) + 3 * m + 1) & 127)) bad |= 2u; } }
    { const int x = lane & 15, kb = lane >> 4; v4i a, b;
#pragma unroll
      for (int q = 0; q < 4; ++q) { unsigned wa = 0, wb = 0;
#pragma unroll
          for (int e = 0; e < 4; ++e) { const int k = 16 * kb + 4 * q + e; wa |= (unsigned)((((x + 2 * k) % 5) - 2) & 255) << (8 * e); wb |= (unsigned)((((3 * k + x) % 7) - 3) & 255) << (8 * e); }
          a[q] = (int)wa; b[q] = (int)wb; }
      v4i c = {0, 0, 0, 0};
      c = __builtin_amdgcn_mfma_i32_16x16x64_i8(a, b, c, 0, 0, 0);
#pragma unroll
      for (int r = 0; r < 4; ++r) { const int i = 4 * kb + r, j = x; int ref = 0;
          for (int k = 0; k < 64; ++k) ref += (((i + 2 * k) % 5) - 2) * (((3 * k + j) % 7) - 3);
          if (c[r] != ref) bad |= 4u; } }
    return bad;
}


#include <type_traits>
#ifndef VPASS_MFMA
#define VPASS_MFMA 1
#endif
#ifndef W8
#define W8 (VPASS_MFMA ? 0 : 1)
#endif
typedef float f32x2 __attribute__((ext_vector_type(2)));
__device__ __forceinline__ int ired8(int (&p)[8], int lane, int s2, int s1, int s0) {
    { const bool up = (lane & s2) != 0;
#pragma unroll
      for (int j = 0; j < 4; ++j) { const int send = up ? p[j] : p[j + 4], keep = up ? p[j + 4] : p[j]; p[j] = keep + __shfl_xor(send, s2); } }
    { const bool up = (lane & s1) != 0;
#pragma unroll
      for (int j = 0; j < 2; ++j) { const int send = up ? p[j] : p[j + 2], keep = up ? p[j + 2] : p[j]; p[j] = keep + __shfl_xor(send, s1); } }
    { const bool up = (lane & s0) != 0; const int send = up ? p[0] : p[1], keep = up ? p[1] : p[0]; p[0] = keep + __shfl_xor(send, s0); }
    return p[0];
}
__device__ __forceinline__ float wave_sum_dpp(float v) {
    v += __int_as_float(__builtin_amdgcn_update_dpp(0, __float_as_int(v), 0x128, 0xf, 0xf, false));
    v += __int_as_float(__builtin_amdgcn_update_dpp(0, __float_as_int(v), 0x124, 0xf, 0xf, false));
    v += __int_as_float(__builtin_amdgcn_update_dpp(0, __float_as_int(v), 0x122, 0xf, 0xf, false));
    v += __int_as_float(__builtin_amdgcn_update_dpp(0, __float_as_int(v), 0x121, 0xf, 0xf, false));
    const int b = __float_as_int(v);
    return (__int_as_float(__builtin_amdgcn_readlane(b, 0)) + __int_as_float(__builtin_amdgcn_readlane(b, 16))) + (__int_as_float(__builtin_amdgcn_readlane(b, 32)) + __int_as_float(__builtin_amdgcn_readlane(b, 48)));
}
__device__ __forceinline__ float gelu_as(float v) {
    const float t = __builtin_amdgcn_rcpf(fabsf(v) * 0.2316418882f + 1.0f);
    float q = t * 0.5307027145f + (-0.7265760135f); q = q * t + 0.7107068705f; q = q * t + (-0.142248368f); q = q * t + 0.127414796f; q = q * t;
    const float m = v * (q * __builtin_amdgcn_exp2f((v * v) * (-0.72134752044f)));
    return v < 0.f ? m : v - m;
}
__device__ __forceinline__ float wave_max_dpp(float v) {
    v = fmaxf(v, __int_as_float(__builtin_amdgcn_update_dpp(0, __float_as_int(v), 0x128, 0xf, 0xf, false)));
    v = fmaxf(v, __int_as_float(__builtin_amdgcn_update_dpp(0, __float_as_int(v), 0x124, 0xf, 0xf, false)));
    v = fmaxf(v, __int_as_float(__builtin_amdgcn_update_dpp(0, __float_as_int(v), 0x122, 0xf, 0xf, false)));
    v = fmaxf(v, __int_as_float(__builtin_amdgcn_update_dpp(0, __float_as_int(v), 0x121, 0xf, 0xf, false)));
    const int b = __float_as_int(v);
    return fmaxf(fmaxf(__int_as_float(__builtin_amdgcn_readlane(b, 0)), __int_as_float(__builtin_amdgcn_readlane(b, 16))), fmaxf(__int_as_float(__builtin_amdgcn_readlane(b, 32)), __int_as_float(__builtin_amdgcn_readlane(b, 48))));
}
__device__ __forceinline__ float wave_max(float v) {
#pragma unroll
    for (int o = 1; o < 64; o <<= 1) v = fmaxf(v, __shfl_xor(v, o));
    return v;
}
__device__ __forceinline__ unsigned q4(float a, float b, float c, float d, float inv, int off) {
    const int qa = (int)rintf(a * inv) + off, qb = (int)rintf(b * inv) + off, qc = (int)rintf(c * inv) + off, qd = (int)rintf(d * inv) + off;
    return (unsigned)(qa & 255) | ((unsigned)(qb & 255) << 8) | ((unsigned)(qc & 255) << 16) | ((unsigned)(qd & 255) << 24);
}
template <int R> __device__ __forceinline__ void quant_table_rows(const float* const (&src)[R], unsigned char* const (&dst)[R], float* const (&sco)[R], const bool (&ok)[R], int lane) {
    f32x4 v[R][4];
#pragma unroll
    for (int r = 0; r < R; ++r) { const f32x4* p = (const f32x4*)src[r] + lane;
#pragma unroll
        for (int j = 0; j < 4; ++j) v[r][j] = p[64 * j]; }
#pragma unroll
    for (int r = 0; r < R; ++r) {
        float am = 0.f;
#pragma unroll
        for (int j = 0; j < 4; ++j) am = fmaxf(am, fmaxf(fmaxf(fabsf(v[r][j].x), fabsf(v[r][j].y)), fmaxf(fabsf(v[r][j].z), fabsf(v[r][j].w))));
        am = wave_max_dpp(am);
        const float sc = am > 0.f ? am * (1.f / 127.f) : 1.f, inv = 1.f / sc;
        if (ok[r]) {
#pragma unroll
            for (int j = 0; j < 4; ++j)
                *(unsigned*)(dst[r] + (size_t)(2 * j + (lane >> 5)) * ((size_t)NEXP * 128) + ((4 * lane) & 127)) = q4(v[r][j].x, v[r][j].y, v[r][j].z, v[r][j].w, inv, 0);
            if (lane == 0) *sco[r] = sc; }
    }
}
template <int R> __device__ __forceinline__ void quant_u4_rows(const float* const (&src)[R], unsigned char* const (&dst)[R], float* const (&sco)[R], const bool (&ok)[R], int lane) {
    f32x4 v[R][4];
#pragma unroll
    for (int r = 0; r < R; ++r) { const f32x4* p = (const f32x4*)src[r] + lane;
#pragma unroll
        for (int j = 0; j < 4; ++j) v[r][j] = p[64 * j]; }
#pragma unroll
    for (int r = 0; r < R; ++r) {
        float ss = 0.f;
#pragma unroll
        for (int j = 0; j < 4; ++j) ss += (v[r][j].x * v[r][j].x + v[r][j].y * v[r][j].y) + (v[r][j].z * v[r][j].z + v[r][j].w * v[r][j].w);
        ss = wave_sum_dpp(ss);
        const float rms = sqrtf(ss * (1.f / 1024.f)); const float sc = rms > 0.f ? rms * (2.6f / 7.f) : 1.f, inv = 1.f / sc;
#pragma unroll
        for (int j = 0; j < 4; ++j) {
            unsigned nib = 0;
            { const float f[4] = {v[r][j].x, v[r][j].y, v[r][j].z, v[r][j].w};
#pragma unroll
              for (int e = 0; e < 4; ++e) { int q = (int)rintf(f[e] * inv); q = q > 7 ? 7 : (q < -7 ? -7 : q); nib |= (unsigned)(q & 15) << (8 * e); } }
            const unsigned other = (unsigned)__shfl_xor((int)nib, 32);
            if (ok[r] && lane < 32) *(unsigned*)(dst[r] + (size_t)j * ((size_t)NEXP * 128) + 4 * lane) = nib | (other << 4);
        }
        if (ok[r] && lane == 0) *sco[r] = sc * (1.f / 16.f);
    }
}
template <int R> __device__ __forceinline__ void quant_x_rows(const bf16* XG, const float* SSQ, const float* gain, unsigned char* XQ, float* SX, const int (&t)[R], const bool (&ok)[R], int lane) {
    const f32x4 gq0 = *(const f32x4*)(gain + 16 * lane), gq1 = *(const f32x4*)(gain + 16 * lane + 4), gq2 = *(const f32x4*)(gain + 16 * lane + 8), gq3 = *(const f32x4*)(gain + 16 * lane + 12);
    const float gq[16] = {gq0[0], gq0[1], gq0[2], gq0[3], gq1[0], gq1[1], gq1[2], gq1[3], gq2[0], gq2[1], gq2[2], gq2[3], gq3[0], gq3[1], gq3[2], gq3[3]};
    u32x4 a[R], b[R]; f32x4 s[R][4];
#pragma unroll
    for (int r = 0; r < R; ++r) { a[r] = *(const u32x4*)(XG + (size_t)t[r] * D + 16 * lane); b[r] = *(const u32x4*)(XG + (size_t)t[r] * D + 16 * lane + 8);
#pragma unroll
        for (int j = 0; j < 4; ++j) s[r][j] = ((const f32x4*)(SSQ + (size_t)t[r] * 16))[j]; }
#pragma unroll
    for (int r = 0; r < R; ++r) {
        const float ssum = (((s[r][0][0] + s[r][0][1]) + (s[r][0][2] + s[r][0][3])) + ((s[r][1][0] + s[r][1][1]) + (s[r][1][2] + s[r][1][3]))) + (((s[r][2][0] + s[r][2][1]) + (s[r][2][2] + s[r][2][3])) + ((s[r][3][0] + s[r][3][1]) + (s[r][3][2] + s[r][3][3])));
        const float rstd = 1.0f / sqrtf(ssum * (1.f / 1024.f) + EPS);
        float f[16] = {bflo(a[r].x), bfhi(a[r].x), bflo(a[r].y), bfhi(a[r].y), bflo(a[r].z), bfhi(a[r].z), bflo(a[r].w), bfhi(a[r].w), bflo(b[r].x), bfhi(b[r].x), bflo(b[r].y), bfhi(b[r].y), bflo(b[r].z), bfhi(b[r].z), bflo(b[r].w), bfhi(b[r].w)};
        float am = 0.f;
#pragma unroll
        for (int i = 0; i < 16; ++i) { f[i] *= rstd * gq[i]; am = fmaxf(am, fabsf(f[i])); }
        am = wave_max_dpp(am);
        const float sc = am > 0.f ? am * (1.f / 127.f) : 1.f, inv = 1.f / sc;
        u32x4 o; o.x = q4(f[0], f[1], f[2], f[3], inv, 0); o.y = q4(f[4], f[5], f[6], f[7], inv, 0); o.z = q4(f[8], f[9], f[10], f[11], inv, 0); o.w = q4(f[12], f[13], f[14], f[15], inv, 0);
        if (ok[r]) { *(u32x4*)(XQ + (size_t)t[r] * D + 16 * lane) = o; if (lane == 0) SX[t[r]] = sc; }
    }
}
struct USmall { u32x4 xl, xh; u32x4 ia, ib; };
__device__ __forceinline__ void phase_upass(const unsigned char* XQ, const unsigned short* IDX, const unsigned char* U8l  , unsigned* PA  , int lane, int wave, int G) {
    const int nr = G >> 3, cg = blockIdx.x & 3, half = (blockIdx.x >> 2) & 1, rk = blockIdx.x >> 3; if (rk >= nr) return;
    const unsigned char* Us = U8l + (size_t)cg * NEXP * 128;
    const unsigned loff = (lane & 7) * 16;
    const int stride = 2 * nr * NWAVES, tfirst = 2 * (rk * NWAVES + wave) + half, n = (T - tfirst + stride - 1) / stride;
    auto ld_small = [&](int t) { USmall r; const unsigned char* xp = XQ + (size_t)t * D + 256 * cg + (lane & 7) * 16; r.xl = *(const u32x4*)xp; r.xh = *(const u32x4*)(xp + 128);
        const u32x4* ip = (const u32x4*)(IDX + (size_t)t * 128 + (lane >> 3) * 16); r.ia = ip[0]; r.ib = ip[1]; return r; };
    u32x4 R[2][16]; USmall S[2];
#define ROWID(sm, k) ((((k) < 8 ? (sm).ia : (sm).ib)[((k) & 7) >> 1] >> (16 * ((k) & 1))) & 0xffffu)
#define UROWS(dst, sm) _Pragma("unroll") for (int k = 0; k < 16; ++k) { const unsigned row = ROWID(sm, k); dst[k] = *(const u32x4*)(Us + (row * 128u + loff)); }
    if (n <= 0) return;
    S[0] = ld_small(tfirst); UROWS(R[0], S[0]);
    S[1] = ld_small(n > 1 ? tfirst + stride : tfirst);
    auto body = [&](auto PP, int i) {
            constexpr int pp = decltype(PP)::value;
            const int t = tfirst + i * stride;
            const USmall S2 = ld_small(tfirst + ((i + 2 < n) ? i + 2 : n - 1) * stride);
            UROWS(R[pp ^ 1], S[pp ^ 1]);
            const u32x4 xl = S[pp].xl, xh = S[pp].xh;
            int rr[2];
#pragma unroll
            for (int hh = 0; hh < 2; ++hh) {
                int p[8];
#pragma unroll
                for (int k = 0; k < 8; ++k) { const u32x4 u = R[pp][8 * hh + k]; int a = 0;
#pragma unroll
                    for (int d = 0; d < 4; ++d) { a = __builtin_amdgcn_sdot4((int)((u[d] << 4) & 0xF0F0F0F0u), (int)xl[d], a, false); a = __builtin_amdgcn_sdot4((int)(u[d] & 0xF0F0F0F0u), (int)xh[d], a, false); }
                    p[k] = a; }
                rr[hh] = ired8(p, lane, 4, 2, 1);
            }
            PA[((size_t)cg * T + t) * 64 + 8 * (lane & 7) + (lane >> 3)] = pk2((float)rr[0], (float)rr[1]);
            S[pp] = S2;
    };
    for (int it = 0; it < n; it += 2) { body(std::integral_constant<int, 0>{}, it); if (it + 1 < n) body(std::integral_constant<int, 1>{}, it + 1); }
#undef UROWS
}
__device__ __forceinline__ void phase_combine(const unsigned* PA, const unsigned short* IDX, const float* GATE, const float* SX, const float* SUl, const float* SVl, unsigned* WP, float* SW, int lane, int wave, int G) {
    const int gw = blockIdx.x * NWAVES + wave, NGW = G * NWAVES;
    const int n = (T - gw + NGW - 1) / NGW;
    struct StA { unsigned pa[4]; int i0, i1; float g0, g1, sx; };
    struct StB { float s0, s1, su0, su1, sv0, sv1, g0, g1, sx; };
    auto ldA = [&](int k) { const int t = gw + (k < n ? k : n - 1) * NGW; StA r;
#pragma unroll
        for (int s = 0; s < 4; ++s) r.pa[s] = PA[((size_t)s * T + t) * 64 + lane];
        r.i0 = (int)IDX[(size_t)t * 128 + (lane & 7) * 16 + (lane >> 3)]; r.i1 = (int)IDX[(size_t)t * 128 + (lane & 7) * 16 + 8 + (lane >> 3)];
        r.g0 = GATE[(size_t)t * 128 + (lane & 7) * 16 + (lane >> 3)]; r.g1 = GATE[(size_t)t * 128 + (lane & 7) * 16 + 8 + (lane >> 3)]; r.sx = SX[t]; return r; };
    auto ldB = [&](const StA& a) { StB r; r.s0 = (bflo(a.pa[0]) + bflo(a.pa[1])) + (bflo(a.pa[2]) + bflo(a.pa[3])); r.s1 = (bfhi(a.pa[0]) + bfhi(a.pa[1])) + (bfhi(a.pa[2]) + bfhi(a.pa[3]));
        r.su0 = SUl[a.i0]; r.su1 = SUl[a.i1]; r.sv0 = SVl[a.i0]; r.sv1 = SVl[a.i1]; r.g0 = a.g0; r.g1 = a.g1; r.sx = a.sx; return r; };
    if (n <= 0) return;
    StA a1 = ldA(0); StB b0 = ldB(a1); a1 = ldA(1); StA a2 = ldA(2);
    for (int k = 0; k < n; ++k) {
        const int t = gw + k * NGW;
        const StB b1 = ldB(a1);
        const StA a3 = ldA(k + 3);
        {
            const float a0 = b0.s0 * b0.sx * b0.su0, a1v = b0.s1 * b0.sx * b0.su1;
            const float w0 = b0.g0 * gelu_as(a0) * b0.sv0;
            const float w1 = b0.g1 * gelu_as(a1v) * b0.sv1;
            const float am = wave_max_dpp(fmaxf(fabsf(w0), fabsf(w1)));
            const float sw = am > 0.f ? am * (1.f / 32639.f) : 1.f, inv = 1.f / sw;
            unsigned char* wb = (unsigned char*)WP + (size_t)t * 256;
            const int f0 = (int)rintf(w0 * inv), f1 = (int)rintf(w1 * inv); const int l0 = ((f0 + 128) & 255) - 128, l1 = ((f1 + 128) & 255) - 128;
#define QUADPACK(b_) ((unsigned)__builtin_amdgcn_update_dpp(0, (int)(b_), 0x00, 0xf, 0xf, false) | ((unsigned)__builtin_amdgcn_update_dpp(0, (int)(b_), 0x55, 0xf, 0xf, false) << 8) | \
                      ((unsigned)__builtin_amdgcn_update_dpp(0, (int)(b_), 0xAA, 0xf, 0xf, false) << 16) | ((unsigned)__builtin_amdgcn_update_dpp(0, (int)(b_), 0xFF, 0xf, 0xf, false) << 24))
            { const unsigned h0 = QUADPACK((unsigned)(((f0 - l0) >> 8) & 255)), h1 = QUADPACK((unsigned)(((f1 - l1) >> 8) & 255)), q0 = QUADPACK((unsigned)(l0 & 255)), q1 = QUADPACK((unsigned)(l1 & 255));
              if ((lane & 3) == 0) { unsigned* wd = (unsigned*)wb + (lane >> 2); wd[0] = h0; wd[16] = h1; wd[32] = q0; wd[48] = q1; } }
#undef QUADPACK
            if (lane == 0) SW[t] = sw;
        }
        b0 = b1; a1 = a2; a2 = a3;
    }
}
#if VPASS_MFMA
constexpr int VP_PITCH = 144, VP_TILE = 128 * VP_PITCH, VP_RED_OFF = NWAVES * VP_TILE;
struct VSmall { u32x4 ia, ib; v4i aw[2]; float sw; u32x2 xv; };
__device__ __forceinline__ void tr8x8_issue(v2i (&r)[8], unsigned a0) {
    asm volatile("ds_read_b64_tr_b8 %0, %8\n\tds_read_b64_tr_b8 %1, %8 offset:1152\n\tds_read_b64_tr_b8 %2, %8 offset:16\n\tds_read_b64_tr_b8 %3, %8 offset:1168\n\t"
                 "ds_read_b64_tr_b8 %4, %8 offset:32\n\tds_read_b64_tr_b8 %5, %8 offset:1184\n\tds_read_b64_tr_b8 %6, %8 offset:48\n\tds_read_b64_tr_b8 %7, %8 offset:1200"
                 : "=&v"(r[0]), "=&v"(r[1]), "=&v"(r[2]), "=&v"(r[3]), "=&v"(r[4]), "=&v"(r[5]), "=&v"(r[6]), "=&v"(r[7]) : "v"(a0) : "memory");
}
#define TR8_WAIT(n, r) asm volatile("s_waitcnt lgkmcnt(" #n ")" : "+v"(r[0]), "+v"(r[1]), "+v"(r[2]), "+v"(r[3]), "+v"(r[4]), "+v"(r[5]), "+v"(r[6]), "+v"(r[7]) :: "memory")
__device__ __forceinline__ void phase_vpass(bf16* x  , const unsigned short* IDX, const unsigned* WP, const float* SW, const unsigned char* V8l,
                                            float* ssq, LAS unsigned char* ldsp, int lane, int wave, int G) {
    const int nr = G >> 3, cg = blockIdx.x & 3, half = (blockIdx.x >> 2) & 1, rk = blockIdx.x >> 3; if (rk >= nr) return;
    const unsigned char* Vs = V8l + (size_t)cg * NEXP * 128;
    const unsigned loff = (lane & 7) * 16;
    const int col = 256 * cg + 4 * lane;
    const int stride = 2 * nr * NWAVES, tfirst = 2 * (rk * NWAVES + wave) + half, n = (T - tfirst + stride - 1) / stride;
    LAS unsigned char* tile = ldsp + wave * VP_TILE; LAS int* red = (LAS int*)(ldsp + VP_RED_OFF + wave * 1024);
    const unsigned wr_off = (unsigned)((lane >> 3) * VP_PITCH + (lane & 7) * 16);
    const unsigned rd_addr = (unsigned)(size_t)tile + (unsigned)((16 * (lane >> 4) + ((lane & 15) >> 1)) * VP_PITCH + 8 * (lane & 1));
    const int ai = lane & 15, akb = lane >> 4;
    auto ld_small = [&](int t) { VSmall r; { const u32x4* ip = (const u32x4*)(IDX + (size_t)t * 128 + (lane >> 3) * 16); r.ia = ip[0]; r.ib = ip[1]; }
        const unsigned char* wb = (const unsigned char*)WP + (size_t)t * 256 + (ai & 1) * 128 + 16 * akb;
        r.aw[0] = *(const v4i*)wb; r.aw[1] = *(const v4i*)(wb + 64);
        if (ai >= 2) { const v4i z = {0, 0, 0, 0}; r.aw[0] = z; r.aw[1] = z; }
        r.sw = SW[t]; r.xv = *(const u32x2*)(x + (size_t)t * D + col); return r; };
    u32x4 R[16]; VSmall Sc, Sn;
#define VROWS(dst, sm) _Pragma("unroll") for (int k = 0; k < 16; ++k) { const unsigned row = ROWID(sm, k); dst[k] = *(const u32x4*)(Vs + (row * 128u + loff)); }
    if (n <= 0) return;
    Sc = ld_small(tfirst); VROWS(R, Sc);
    Sn = ld_small(n > 1 ? tfirst + stride : tfirst);
    for (int i = 0; i < n; ++i) {
            const int t = tfirst + i * stride;
            const VSmall S2 = ld_small(tfirst + ((i + 2 < n) ? i + 2 : n - 1) * stride);
#pragma unroll
            for (int k = 0; k < 16; ++k) *(LAS u32x4*)(tile + wr_off + k * 8 * VP_PITCH) = R[k];
            asm volatile("" ::: "memory");
            VROWS(R, Sn);
            v4i al[8], ah[8];
#pragma unroll
            for (int q = 0; q < 8; ++q) { al[q] = (v4i){0, 0, 0, 0}; ah[q] = (v4i){0, 0, 0, 0}; }
            { v2i ra[8], rb[8], rc[8], rd[8];
              const v4i a0 = Sc.aw[0], a1 = Sc.aw[1];
#define MM4(rr, aa, base) _Pragma("unroll") for (int q = 0; q < 4; ++q) { const v4i b_ = {rr[2 * q][0], rr[2 * q][1], rr[2 * q + 1][0], rr[2 * q + 1][1]}; \
                  const v4i bl_ = {(int)(((unsigned)b_[0] << 4) & 0xF0F0F0F0u), (int)(((unsigned)b_[1] << 4) & 0xF0F0F0F0u), (int)(((unsigned)b_[2] << 4) & 0xF0F0F0F0u), (int)(((unsigned)b_[3] << 4) & 0xF0F0F0F0u)}; \
                  const v4i bh_ = {(int)((unsigned)b_[0] & 0xF0F0F0F0u), (int)((unsigned)b_[1] & 0xF0F0F0F0u), (int)((unsigned)b_[2] & 0xF0F0F0F0u), (int)((unsigned)b_[3] & 0xF0F0F0F0u)}; \
                  al[base + q] = __builtin_amdgcn_mfma_i32_16x16x64_i8(aa, bl_, al[base + q], 0, 0, 0); ah[base + q] = __builtin_amdgcn_mfma_i32_16x16x64_i8(aa, bh_, ah[base + q], 0, 0, 0); }
              tr8x8_issue(ra, rd_addr); tr8x8_issue(rb, rd_addr + 64);
              TR8_WAIT(8, ra); MM4(ra, a0, 0)
              tr8x8_issue(rc, rd_addr + 64 * VP_PITCH);
              TR8_WAIT(8, rb); MM4(rb, a0, 4)
              tr8x8_issue(rd, rd_addr + 64 * VP_PITCH + 64);
              TR8_WAIT(8, rc); MM4(rc, a1, 0)
              TR8_WAIT(0, rd); MM4(rd, a1, 4)
#undef MM4
            }
            if (lane < 16) {
#pragma unroll
                for (int q = 0; q < 8; ++q) { red[16 * q + lane] = al[q][0] * 256 + al[q][1]; red[128 + 16 * q + lane] = ah[q][0] * 256 + ah[q][1]; } }
            asm volatile("s_waitcnt lgkmcnt(0)" ::: "memory");
            const v4i o4 = *(const LAS v4i*)(red + 4 * lane);
            const float sw = Sc.sw;
            const float x0 = bflo(Sc.xv.x) + sw * (float)o4[0], x1 = bfhi(Sc.xv.x) + sw * (float)o4[1], x2 = bflo(Sc.xv.y) + sw * (float)o4[2], x3 = bfhi(Sc.xv.y) + sw * (float)o4[3];
            *(u32x2*)(x + (size_t)t * D + col) = (u32x2){pk2(x0, x1), pk2(x2, x3)};
            { const float qs = wave_sum_dpp((x0 * x0 + x1 * x1) + (x2 * x2 + x3 * x3)); if (lane == 0) ssq[(size_t)t * 16 + cg] = qs; }
            Sc = Sn; Sn = S2;
    }
#undef VROWS
}
#endif
__device__ __forceinline__ void phase_final_norm(const bf16* X, const float* ssq, const float* g, float* out, int lane, int wave, int G) {
    const int gw = blockIdx.x * NWAVES + wave, NGW = G * NWAVES;
    constexpr int R = 4;
    f32x4 gv[4];
#pragma unroll
    for (int j = 0; j < 4; ++j) gv[j] = ((const f32x4*)g)[64 * j + lane];
    for (int rb = gw; rb < T; rb += R * NGW) {
        u32x2 v[R][4]; f32x4 s0[R], s1[R];
#pragma unroll
        for (int u = 0; u < R; ++u) { const int r = (rb + u * NGW < T) ? rb + u * NGW : rb; const u32x2* xr = (const u32x2*)(X + (size_t)r * D) + lane;
#pragma unroll
            for (int j = 0; j < 4; ++j) v[u][j] = xr[64 * j];
            s0[u] = ((const f32x4*)(ssq + (size_t)r * 16))[0]; s1[u] = ((const f32x4*)(ssq + (size_t)r * 16))[1]; }
#pragma unroll
        for (int u = 0; u < R; ++u) { const int r = rb + u * NGW; if (r >= T) continue; f32x4* orow = (f32x4*)(out + (size_t)r * D) + lane;
            const float ss = ((s0[u][0] + s0[u][1]) + (s0[u][2] + s0[u][3])) + ((s1[u][0] + s1[u][1]) + (s1[u][2] + s1[u][3]));
            const float rstd = 1.0f / sqrtf(ss * (1.f / D) + EPS);
#pragma unroll
            for (int j = 0; j < 4; ++j) { const f32x4 xv = {bflo(v[u][j].x), bfhi(v[u][j].x), bflo(v[u][j].y), bfhi(v[u][j].y)}; orow[64 * j] = xv * rstd * gv[j]; } }
    }
}


__device__ __forceinline__ void phase_attn_mem(const bf16* Zq, int qp, int qcol, const bf16* MKVl, bf16* YC, char* lds, int vcu, int G) {
    for (int u = vcu; u < BATCH * MEMH * 16; u += G) {
        const int bh = u >> 4, qb = u & 15; const int b = bh >> 2, h = bh & 3;
        attn_body::AttnArgs A;
        A.Q = (const attn_body::bf16*)(Zq + ((size_t)b * SEQ + qb * 256) * qp + qcol + h * 64);
        A.K = (const attn_body::bf16*)(MKVl + (size_t)b * NMEM * 512 + h * 64); A.V = A.K + 256;
        A.O = (attn_body::bf16*)(YC + ((size_t)b * SEQ + qb * 256) * D + 768 + h * 64);
        A.cs = nullptr; A.qp = qp; A.kp = 512; A.op = D; A.q0 = qb * 256; A.bound = 0.f;
        attn_body::attn_unit<8, false>(A, lds);
    }
}
__device__ __forceinline__ void phase_headnorm_max(const bf16* X, int pitch, unsigned* out, int lane, int wave, int G) {
    const int gw = blockIdx.x * NWAVES + wave, NGW = G * NWAVES;
    for (int task = gw; task < BATCH * FOXH * 16; task += NGW) {
        const int bh = task >> 4, ch = task & 15; const int b = bh / FOXH, h = bh % FOXH; float mx = 0.f;
#pragma unroll
        for (int i = 0; i < 4; ++i) { const bf16* rp = X + ((size_t)b * SEQ + ch * 256 + i * 64 + lane) * pitch + h * 64; float ss = 0.f;
#pragma unroll
            for (int c = 0; c < 8; ++c) { const u32x4 v = *(const u32x4*)(rp + 8 * c);
                ss += bflo(v.x) * bflo(v.x) + bfhi(v.x) * bfhi(v.x) + bflo(v.y) * bflo(v.y) + bfhi(v.y) * bfhi(v.y) + bflo(v.z) * bflo(v.z) + bfhi(v.z) * bfhi(v.z) + bflo(v.w) * bflo(v.w) + bfhi(v.w) * bfhi(v.w); }
            mx = fmaxf(mx, ss); }
        mx = wave_max(mx);
        if (lane == 0) atomicMax(out + bh, __float_as_uint(mx));
    }
}
__device__ __forceinline__ void phase_attn_fox(const bf16* Zq, const bf16* KVb, const float* C2v, const unsigned* QM2, const unsigned* KM2, bf16* YC, char* lds, int vcu, int G) {
    for (int p = vcu; p < BATCH * FOXH * 8; p += G) {
        const int bh = p >> 3, s = p & 7; const int b = bh / FOXH, h = bh % FOXH;
        const float bound = sqrtf(__uint_as_float(QM2[bh]) * __uint_as_float(KM2[bh])) * 1.001f + 0.01f;
#pragma nounroll
        for (int k = 0; k < 2; ++k) {
            const int qb = k ? 15 - s : s;
            attn_body::AttnArgs A;
            A.Q = (const attn_body::bf16*)(Zq + ((size_t)b * SEQ + qb * 256) * NB + h * 64);
            A.K = (const attn_body::bf16*)(KVb + (size_t)b * SEQ * 1536 + h * 64); A.V = A.K + 768;
            A.O = (attn_body::bf16*)(YC + ((size_t)b * SEQ + qb * 256) * D + h * 64);
            A.cs = C2v + (size_t)bh * SEQ; A.qp = NB; A.kp = 1536; A.op = D; A.q0 = qb * 256; A.bound = bound;
            attn_body::attn_unit<8, true>(A, lds);
        }
    }
}


#ifndef SELFTEST
#define SELFTEST 0
#endif
#ifndef PROBE_K
#define PROBE_K -99
#endif
#ifndef PROBE_T
#define PROBE_T -99
#endif
#ifndef PROBE_L
#define PROBE_L -1
#endif
#ifndef PROBE_SKEW
#define PROBE_SKEW 0
#endif
#ifndef ROUTE_WAVES
#define ROUTE_WAVES 6
#endif
#ifndef PROBE_MODE
#define PROBE_MODE 0
#endif
#ifndef PROBE_N
#define PROBE_N 1
#endif
#define REPS(k) for (int rep_ = 0; rep_ < ((k) == PROBE_K ? 1 + PROBE_N : 1); ++rep_)
#ifndef SITES
#define SITES 0xFFFF
#endif
struct Args { const float* in[18]; float* out; unsigned char* ws; int ph_lo, ph_hi, use_bar, pad; };
__global__ void __launch_bounds__(NWAVES * 64, 2) mk_fwd(Args args) {
    extern __shared__ __attribute__((aligned(16))) unsigned char lds[];
    LAS unsigned char* const ldsp = (LAS unsigned char*)lds;
    volatile LAS unsigned* const MISC = (volatile LAS unsigned*)(ldsp + MISC_OFF);
    const int tid = threadIdx.x; const int G = gridDim.x; const int lane = tid & 63; const int wave = __builtin_amdgcn_readfirstlane(tid >> 6);
    gu32* const ctl = (gu32*)(args.ws + WS_CTL);
    for (int u = tid; u < (LDS_BYTES - LDSCTL_OFF) / 4; u += NWAVES * 64) ((LAS unsigned*)(ldsp + LDSCTL_OFF))[u] = 0u;
    __syncthreads();
    XcdBarrier bar; bar.bar = (unsigned*)(ctl + CW_BAR); bar.x = 0; bar.st = nullptr;
    if (args.use_bar) bar = xcd_barrier_post((unsigned*)(ctl + CW_BAR), MISC + 8);
    const int lo = args.ph_lo, hi = args.ph_hi;
#define IN(k) (lo <= (k) && (k) < hi)
    int curL_ = -1;
    volatile LAS unsigned long long* const tw_ = (volatile LAS unsigned long long*)(ldsp + MISC_OFF + 64);
    if (PROBE_T != -99 && blockIdx.x == 0 && threadIdx.x == 0) { tw_[0] = 0ull; tw_[1] = __builtin_amdgcn_s_memrealtime(); }
#define PHID(k) ((k) < PH_L0 ? 100 + (k) : ((k) - PH_L0) % PH_PER_LAYER)
#define TICK(id) do { if (PROBE_T != -99 && blockIdx.x == 0 && threadIdx.x == 0) { const unsigned long long now_ = __builtin_amdgcn_s_memrealtime(); if (!PROBE_SKEW && (id) == PROBE_T && (PROBE_L < 0 || curL_ == PROBE_L)) tw_[0] += now_ - tw_[1]; tw_[1] = now_; } } while (0)
#define ARRIVE(id) do { if (PROBE_SKEW && PROBE_T != -99 && (id) == PROBE_T && (PROBE_L < 0 || curL_ == PROBE_L) && threadIdx.x == 0) ((unsigned long long*)(ctl + 32768))[blockIdx.x] = __builtin_amdgcn_s_memrealtime(); } while (0)
#define SKEW(id) do { if (PROBE_SKEW && PROBE_T != -99 && (id) == PROBE_T && (PROBE_L < 0 || curL_ == PROBE_L) && blockIdx.x == 0 && threadIdx.x == 0) { unsigned long long mx_ = 0ull, sm_ = 0ull; \
    for (int q_ = 0; q_ < G; ++q_) { const unsigned long long s_ = __hip_atomic_load((unsigned long long*)(ctl + 32768) + q_, RLX_AGENT); mx_ = s_ > mx_ ? s_ : mx_; sm_ += s_; } tw_[0] += mx_ - sm_ / (unsigned long long)G; } } while (0)
#define SEAM(k) do { if (IN(k) && IN((k) + 1)) { ARRIVE(PHID(k)); xcd_barrier(bar); SKEW(PHID(k)); TICK(PHID(k)); } } while (0)
#define FRESH_WS(w) GAS unsigned char* w##_g = (GAS unsigned char*)args.ws; asm volatile("" : "+s"(w##_g)); unsigned char* const w = (unsigned char*)w##_g
#define FRESH_INT(v, e) int v = (e); asm volatile("" : "+s"(v))
#define FRESH_TID(t, ln, wv) int t = threadIdx.x; asm volatile("" : "+v"(t)); const int ln = t & 63; const int wv = __builtin_amdgcn_readfirstlane(t >> 6)

#if SELFTEST
    if (IN(PH_PRO) && blockIdx.x == 0) { FRESH_TID(t_, l_, w_); if (w_ == 0) { const unsigned bad = selftest_layouts(ldsp, l_); if (bad & SELFTEST) atomicOr((unsigned*)(ctl + CW_CODE), bad); } }
    __syncthreads();
#endif
    if ((SITES & 64) && IN(PH_PRO)) { FRESH_WS(w); FRESH_TID(t_, l_, w_); phase_prologue(args.in, w, ldsp, t_, l_, w_, G); }
    SEAM(PH_PRO);
    if ((SITES & 1) && IN(PH_MEMKV)) {
        FRESH_WS(w);
        pg8::Gemm g{(bf16*)(w + WS_MN), (bf16*)(w + WS_WMKV), 4 * 2048, 4 * 512, D}; pg8::MemKvOrder S{G, (int)blockIdx.x};
        pg8::EpiStore E{(bf16*)(w + WS_MKV), 512, 512, 1 << 30, 1.f};
        pg8::gemm_phase<pg8::EpiStore, pg8::MemKvOrder, true, true>(ldsp + RING_OFF, g, S, E);
    }
    SEAM(PH_MEMKV);
    for (int L = 0; L < 4; ++L) {
        const int pb = PH_L0 + PH_PER_LAYER * L; if (PROBE_T != -99) curL_ = L;
        REPS(0) if (IN(pb + 0)) {
            if ((SITES & 2) && L < 2) {
                FRESH_WS(w); FRESH_INT(l, L);
                pg8::Gemm g{(bf16*)(w + WS_X), (bf16*)(w + WS_WINA) + (size_t)l * NA * D, T, NA, D}; pg8::StaticOrder S; S.init(T, NA, G, (int)blockIdx.x);
                pg8::EpiStore E{(bf16*)(w + WS_Z), NA, 1 << 30, 2304, C2, (const float*)(w + WS_SSQB), 8};
                pg8::gemm_phase<pg8::EpiStore, pg8::StaticOrder, true, true>(ldsp + RING_OFF, g, S, E);
            } else if (L >= 2) {
                if ((SITES & 4) && L == 2) {
                    FRESH_WS(w);
                    pg8::Gemm g{(bf16*)(w + WS_X), (bf16*)(w + WS_WKV), T, NKVP, D}; pg8::StaticOrder S; S.init(T, NKVP, G, (int)blockIdx.x);
                    pg8::EpiKV E{(bf16*)(w + WS_KV), args.in[11], (float*)(w + WS_LOGF), (const float*)(w + WS_SSQB), 8};
                    pg8::gemm_phase<pg8::EpiKV, pg8::StaticOrder, true, true>(ldsp + RING_OFF, g, S, E);
                    __syncthreads();
                }
                if (SITES & 8) {
                FRESH_WS(w); FRESH_INT(l, L - 2);
                pg8::Gemm g{(bf16*)(w + WS_X), (bf16*)(w + WS_WINB) + (size_t)l * NB * D, T, NB, D}; pg8::StaticOrder S; S.init(T, NB, G, (int)blockIdx.x);
                pg8::EpiStore E{(bf16*)(w + WS_Z), NB, 1 << 30, 0, C2, (const float*)(w + WS_SSQB), 8};
                pg8::gemm_phase<pg8::EpiStore, pg8::StaticOrder, true, true>(ldsp + RING_OFF, g, S, E);
                }
            }
        }
        if (PROBE_K == 0 && IN(pb + 0) && L < 2) { __syncthreads();
                FRESH_WS(w); const int l = L;
                pg8::Gemm g{(bf16*)(w + WS_X), (bf16*)(w + WS_WINA) + (size_t)l * NA * D, T, NA, D}; pg8::StaticOrder S; S.init(T, NA, G, (int)blockIdx.x);
                pg8::EpiStore E{(bf16*)(w + WS_Z), NA, 1 << 30, 2304, C2, (const float*)(w + WS_SSQB), 8};
                pg8::gemm_phase<pg8::EpiStore, pg8::StaticOrder, true, true>(ldsp + RING_OFF, g, S, E); }
        if (L >= 2) SEAM(pb + 0); else { if (IN(pb + 0) && IN(pb + 2)) { ARRIVE(0); xcd_barrier(bar); SKEW(0); TICK(0); } }
        if ((SITES & 128) && IN(pb + 1) && L >= 2) { FRESH_WS(w); FRESH_INT(l, L); FRESH_TID(t_, l_, w_);
            if (l == 2) { phase_cumsum((const float*)(w + WS_LOGF), (float*)(w + WS_C2), l_, w_, G); phase_headnorm_max((const bf16*)(w + WS_KV), 1536, (unsigned*)(ctl + CW_KM2), l_, w_, G); }
            phase_headnorm_max((const bf16*)(w + WS_Z), NB, (unsigned*)(ctl + CW_QM2) + (l - 2) * 128, l_, w_, G); }
        if (L >= 2) SEAM(pb + 1);
        REPS(2) if (IN(pb + 2)) {
            if (SITES & 4096) { FRESH_WS(w); FRESH_INT(l, L); const int vcu = (G % 8 == 0) ? ((int)blockIdx.x % 8) * (G / 8) + (int)blockIdx.x / 8 : (int)blockIdx.x;
                phase_attn_mem((const bf16*)(w + WS_Z), (l < 2) ? NA : NB, (l < 2) ? 2304 : 768, (const bf16*)(w + WS_MKV) + (size_t)l * 2048 * 512, (bf16*)(w + WS_YCAT), (char*)lds, vcu, G); }
            if ((SITES & 8192) && L >= 2) { FRESH_WS(w); const int vcu = (G % 8 == 0) ? ((int)blockIdx.x % 8) * (G / 8) + (int)blockIdx.x / 8 : (int)blockIdx.x;
                phase_attn_fox((const bf16*)(w + WS_Z), (const bf16*)(w + WS_KV), (const float*)(w + WS_C2), (const unsigned*)(ctl + CW_QM2) + (L - 2) * 128, (const unsigned*)(ctl + CW_KM2), (bf16*)(w + WS_YCAT), (char*)lds, vcu, G); }
            if ((SITES & 256) && L < 2) { FRESH_WS(w); FRESH_INT(l, L); FRESH_TID(t_, l_, w_); phase_conv((const bf16*)(w + WS_Z), args.in[4] + (size_t)l * 3 * 768, (bf16*)(w + WS_YCAT), t_, G); }
        }
        SEAM(pb + 2);
        if (PROBE_K == 20 && args.use_bar) { for (int q = 0; q < 10; ++q) xcd_barrier(bar); }
        if ((SITES & 16) && IN(pb + 3)) {
            FRESH_WS(w); FRESH_INT(l, L);
            pg8::Gemm g{(bf16*)(w + WS_YCAT), (bf16*)(w + WS_WOUT) + (size_t)l * D * D, T, D, D}; pg8::StaticOrder S; S.init(T, D, G, (int)blockIdx.x);
            pg8::EpiResid E{(bf16*)(w + WS_X), D, (float*)(w + WS_SSQA)};
            pg8::gemm_phase<pg8::EpiResid, pg8::StaticOrder, true, true>(ldsp + RING_OFF, g, S, E);
        }
        if (PROBE_K == 3 && IN(pb + 3)) { __syncthreads();
            FRESH_WS(w); FRESH_INT(l, L);
            pg8::Gemm g{(bf16*)(w + WS_YCAT), (bf16*)(w + WS_WOUT) + (size_t)l * D * D, T, D, D}; pg8::StaticOrder S; S.init(T, D, G, (int)blockIdx.x);
            pg8::EpiResid E{(bf16*)(w + WS_PQ), D, (float*)(w + WS_SSQB)};
            pg8::gemm_phase<pg8::EpiResid, pg8::StaticOrder, true, true>(ldsp + RING_OFF, g, S, E); }
        SEAM(pb + 3);
        REPS(4) if ((SITES & 32) && IN(pb + 4)) {
            FRESH_WS(w); FRESH_INT(l, L);
            pg8::Gemm g{(bf16*)(w + WS_X), (bf16*)(w + WS_WPQ) + (size_t)l * NPQ * D, T, NPQ, D}; pg8::StaticOrder S; S.init(T, NPQ, G, (int)blockIdx.x);
            pg8::EpiStore E{(bf16*)(w + WS_PQ), NPQ, 1 << 30, 1 << 30, 1.f, (const float*)(w + WS_SSQA), 16};
            pg8::gemm_phase<pg8::EpiStore, pg8::StaticOrder, true, true>(ldsp + RING_OFF, g, S, E);
        }
        SEAM(pb + 4);
        REPS(5) if ((SITES & 1024) && IN(pb + 5)) { FRESH_WS(w); FRESH_INT(l, L); FRESH_TID(t_, l_, w_);
            static_assert(T == 2 * NEXP, "the row items are numbered for equally many table and activation rows");
            LAS int* const wq = (LAS int*)(ldsp + MISC_OFF + 128);
            if (t_ == 0) { int z_ = 0; asm volatile("" : "+v"(z_)); wq[0] = z_; wq[1] = z_; }
            route_stage_keys((const bf16*)(w + WS_PKEYS) + (size_t)l * 8 * 2 * 128 * 128, ldsp, t_);
            __syncthreads();
            const int nb8 = G >> 3, grp = (int)blockIdx.x >> 3, NGW_ = G * NWAVES;
            int mode = (w_ < ROUTE_WAVES) ? 0 : 1, switched = 0;
            for (;;) {
                int it = 0; if (l_ == 0) it = __hip_atomic_fetch_add(wq + mode, 1, __ATOMIC_RELAXED, __HIP_MEMORY_SCOPE_WORKGROUP);
                it = __builtin_amdgcn_readfirstlane(it);
                int ln = l_; asm volatile("" : "+v"(ln));
                GAS unsigned char* wi_g = (GAS unsigned char*)w; asm volatile("" : "+s"(wi_g)); unsigned char* const wi = (unsigned char*)wi_g;
                if (mode == 0) {
                    const int tile = grp * 8 + (it & 7) + (it >> 3) * nb8 * 8;
                    if (grp < nb8 && tile < T / 32) { route_tile((const bf16*)(wi + WS_PQ), (unsigned short*)(wi + WS_IDX), (float*)(wi + WS_GATE), ldsp, tile, ln, w_); continue; }
                } else {
                    constexpr int R = 4; const int wv = it & 7, rb = (int)blockIdx.x * NWAVES + wv + (it >> 4) * R * NGW_;
                    if (((it >> 3) & 1) == 0) { if (rb < 2 * NEXP) { quant_table_item(args.in, wi, l, rb, NGW_, ln); continue; } }
                    else if (rb < T) { int tt[R]; bool ok[R];
#pragma unroll
                        for (int u = 0; u < R; ++u) { tt[u] = rb + u * NGW_; ok[u] = tt[u] < T; if (!ok[u]) tt[u] = rb; }
                        quant_x_rows<R>((const bf16*)(wi + WS_X), (const float*)(wi + WS_SSQA), args.in[12] + (size_t)l * D, (unsigned char*)(wi + WS_XQ), (float*)(wi + WS_SX), tt, ok, ln); continue; }
                    else if (rb < 2 * NEXP) continue;
                }
                if (switched) break; switched = 1; mode ^= 1;
            } }
        SEAM(pb + 5);
        REPS(6) if ((SITES & 2048) && IN(pb + 6)) { FRESH_WS(w); FRESH_INT(l, L); FRESH_TID(t_, l_, w_);
            phase_upass((const unsigned char*)(w + WS_XQ), (const unsigned short*)(w + WS_IDX), (const unsigned char*)(w + WS_U8) + (size_t)l * 4 * NEXP * 128, (unsigned*)(w + WS_PA), l_, w_, G); }
        SEAM(pb + 6);
        REPS(7) if ((SITES & 2048) && IN(pb + 7)) { FRESH_WS(w); FRESH_INT(l, L); FRESH_TID(t_, l_, w_);
            phase_combine((const unsigned*)(w + WS_PA), (const unsigned short*)(w + WS_IDX), (const float*)(w + WS_GATE), (const float*)(w + WS_SX), (const float*)(w + WS_SU) + (size_t)l * NEXP, (const float*)(w + WS_SV) + (size_t)l * NEXP,
                          (unsigned*)(w + WS_W), (float*)(w + WS_WSUM), l_, w_, G); }
        SEAM(pb + 7);
        if (PROBE_K == 8 && IN(pb + 8)) { FRESH_WS(w); FRESH_INT(l, L); FRESH_TID(t_, l_, w_);
            phase_vpass((bf16*)(w + WS_PQ), (const unsigned short*)(w + WS_IDX), (const unsigned*)(w + WS_W), (const float*)(w + WS_WSUM), (const unsigned char*)(w + WS_V8) + (size_t)l * 4 * NEXP * 128, (float*)(w + WS_SSQA), ldsp, l_, w_, G); __syncthreads(); }
        if ((SITES & 2048) && IN(pb + 8)) { FRESH_WS(w); FRESH_INT(l, L); FRESH_TID(t_, l_, w_);
            phase_vpass((bf16*)(w + WS_X), (const unsigned short*)(w + WS_IDX), (const unsigned*)(w + WS_W), (const float*)(w + WS_WSUM), (const unsigned char*)(w + WS_V8) + (size_t)l * 4 * NEXP * 128, (float*)(w + WS_SSQB), ldsp, l_, w_, G); }
        if (L < 3) { if (IN(pb + 8) && IN(pb + PH_PER_LAYER)) { ARRIVE(8); xcd_barrier(bar); SKEW(8); TICK(8); } }
        else {
            SEAM(pb + 8);
            if ((SITES & 2048) && IN(pb + 9)) { FRESH_WS(w); FRESH_TID(t_, l_, w_); phase_final_norm((const bf16*)(w + WS_X), (const float*)(w + WS_SSQB), args.in[17], args.out, l_, w_, G); }
#if SELFTEST
            if (IN(pb + 9)) { __syncthreads(); FRESH_TID(t_, l_, w_); if (__hip_atomic_load(ctl + CW_CODE, RLX_AGENT) != 0u && blockIdx.x == 0) { for (int i = t_; i < 4096; i += NWAVES * 64) args.out[i] = __builtin_nanf(""); } }
#endif
        }
    }
    if (PROBE_T != -99 && args.use_bar) {
        TICK(9);
        if (blockIdx.x == 0 && threadIdx.x == 0) { const unsigned long long t0_ = __builtin_amdgcn_s_memrealtime(); const unsigned long long hold_ = 4ull * tw_[0]; while (__builtin_amdgcn_s_memrealtime() - t0_ < hold_) __builtin_amdgcn_s_sleep(8); }
        xcd_barrier(bar);
    }
#undef IN
#undef SEAM
}

#ifndef ONE_LAUNCH
#define ONE_LAUNCH 1
#endif
static int g_grid = 0;
static void launch_phases(Args a, int lo, int hi, hipStream_t stream) {
    a.ph_lo = lo; a.ph_hi = hi; a.use_bar = (hi - lo > 1) ? 1 : 0;
    hipLaunchKernelGGL(mk_fwd, dim3(g_grid), dim3(NWAVES * 64), LDS_BYTES, stream, a);
}
extern "C" void kernel_launch(void* const* d_in, const int* in_sizes, int n_in, void* d_out, int out_size, void* d_ws, size_t ws_size, hipStream_t stream) {
    if (n_in != 18 || out_size != T * D || ws_size < WS_END) { fprintf(stderr, "kernel_launch: unexpected shapes (n_in %d out %d ws %zu)\n", n_in, out_size, ws_size); return; }
    if (g_grid == 0) {
        int dev = 0, cus = 0;
        if (hipGetDevice(&dev) != hipSuccess || hipDeviceGetAttribute(&cus, hipDeviceAttributeMultiprocessorCount, dev) != hipSuccess) { g_grid = -1; return; }
        if (hipFuncSetAttribute((const void*)mk_fwd, hipFuncAttributeMaxDynamicSharedMemorySize, LDS_BYTES) != hipSuccess) { fprintf(stderr, "kernel_launch: hipFuncSetAttribute failed\n"); g_grid = -1; return; }
        int per_cu = 0;
        if (hipOccupancyMaxActiveBlocksPerMultiprocessor(&per_cu, (const void*)mk_fwd, NWAVES * 64, LDS_BYTES) != hipSuccess || per_cu < 1) fprintf(stderr, "kernel_launch: occupancy query says %d\n", per_cu);
        (void)hipGetLastError();
        g_grid = cus;
    }
    if (g_grid < 0) return;
    (void)hipMemsetAsync((unsigned char*)d_ws + WS_CTL, 0, CTL_ZERO_BYTES, stream);
    Args a{}; for (int i = 0; i < 18; ++i) a.in[i] = (const float*)d_in[i]; a.out = (float*)d_out; a.ws = (unsigned char*)d_ws;
#if ONE_LAUNCH
    launch_phases(a, 0, PH_END, stream);
#else
    for (int p = 0; p < PH_END; ++p) launch_phases(a, p, p + 1, stream);
#endif
}
```

```cpp
#include <hip/hip_runtime.h>
#include <cstdio>
#include <cstdint>

constexpr int BATCH = 8, SEQ = 4096, T = BATCH * SEQ, D = 1024;
constexpr int NA = 2560, NB = 1024, NKV = 1548, NKVP = 1792, NPQ = 2048, NMEM = 256;
constexpr int FOXH = 12, MEMH = 4, PH = 8, PK = 16, NEXP = 16384;
constexpr float EPS = 1e-6f;
constexpr float C2 = 0.125f * 1.4426950408889634f;
constexpr float LOG2E = 1.4426950408889634f;


namespace pg8 {
#define PG8_LAS __attribute__((address_space(3)))
typedef unsigned short bf16_t;
typedef short bf16x8 __attribute__((ext_vector_type(8)));
typedef float f32x4 __attribute__((ext_vector_type(4)));
typedef unsigned u32x4 __attribute__((ext_vector_type(4)));
constexpr int BM = 256, BK = 64, HALF = 128, HTB = HALF * BK * 2  , STAGE_BYTES = 8 * HTB, NXCD = 8, WGM = 4;

__host__ __device__ __forceinline__ int lds_byte(int r, int c) { const int st = (r >> 4) * 2 + (c >> 5), rr = r & 15, cc = c & 31, ob = rr * 64 + cc * 2; return st * 1024 + (ob ^ (((ob >> 9) & 1) << 5)); }
__host__ __device__ __forceinline__ void stage_rc(int b, int& R, int& C) { const int st = b / 1024, sb = b % 1024, swz = sb ^ (((sb >> 9) & 1) << 5); R = (st >> 1) * 16 + swz / 64; C = (st & 1) * 32 + (swz % 64) / 2; }
__host__ __device__ __forceinline__ int perm32(int rho) { const int n = rho >> 4, i = rho & 15; return 8 * (i >> 2) + 4 * n + (i & 3); }

struct Unit { int pm, pn; };
struct Gemm { const bf16_t* A; const bf16_t* Bt; int M, N, K; };

struct StaticOrder {
    int nM, nN, nwg, G, c;
    __host__ __device__ void init(int M, int N, int G_, int c_) { nM = M / BM; nN = N / BM; nwg = nM * nN; G = G_; c = c_; }
    __host__ __device__ bool next(int i, Unit& u) const {
        const long L = (long)i * G + c; if (L >= nwg) return false;
        int wgid = (int)L; { const int q = nwg / NXCD, r = nwg % NXCD, xcd = wgid % NXCD, off = wgid / NXCD; wgid = (xcd < r ? xcd * (q + 1) : r * (q + 1) + (xcd - r) * q) + off; }
        const int nig = WGM * nN, gid = wgid / nig, fm = gid * WGM, gsz = (nM - fm) < WGM ? (nM - fm) : WGM;
        u.pm = fm + ((wgid % nig) % gsz); u.pn = (wgid % nig) / gsz; return true;
    }
    __device__ __forceinline__ void a_ready(const Unit&) const {}
    __device__ __forceinline__ void done(const Unit&) const {}
};

__device__ __forceinline__ unsigned cvt_pk_bf16(float lo, float hi) { unsigned r; asm volatile("v_cvt_pk_bf16_f32 %0, %1, %2" : "=v"(r) : "v"(lo), "v"(hi)); return r; }

__device__ __forceinline__ void row_rstd(float (&rs)[2][4], const float* ssq, int nslots, int row0) {
#pragma unroll
    for (int ai = 0; ai < 2; ++ai)
#pragma unroll
        for (int m = 0; m < 4; ++m) {
            if (ssq) { const f32x4* sp = (const f32x4*)(ssq + (size_t)(row0 + ai * HALF + m * 16) * 16); const f32x4 a = sp[0], b = sp[1]; float s = ((a[0] + a[1]) + (a[2] + a[3])) + ((b[0] + b[1]) + (b[2] + b[3]));
                if (nslots == 16) { const f32x4 c = sp[2], d = sp[3]; s += ((c[0] + c[1]) + (c[2] + c[3])) + ((d[0] + d[1]) + (d[2] + d[3])); }
                rs[ai][m] = 1.0f / sqrtf(s * (1.f / 1024.f) + EPS); }
            else rs[ai][m] = 1.f;
        }
}
struct EpiStore {
    static constexpr bool PERM = true, AFTER_DRAIN = false;
    bf16_t* O; int ldc; int wrap; int scale_from; float scale; const float* ssq; int nslots; PG8_LAS unsigned char* stage;
    __device__ __forceinline__ void operator()(const f32x4 (&acc)[2][2][4][2], const Unit& u, int wr, int wc, int fr, int fq) const {
        const int rowb = u.pm * BM + wr * 64; const int colt = (u.pn * BM) % wrap;
        const float sc = (u.pn * BM >= scale_from) ? scale : 1.f;
        const int lane = fr + 16 * fq; PG8_LAS unsigned char* st = stage + (wr * 4 + wc) * 2048;
        const unsigned woff = (unsigned)(4 * fr + fq) * 16u, roff = (unsigned)lane * 16u;
        const int prow = lane >> 2, col0 = colt + wc * 32 + 8 * (lane & 3);
        float rs[2][4]; row_rstd(rs, ssq, nslots, rowb + fr);
#pragma unroll
        for (int ai = 0; ai < 2; ++ai)
#pragma unroll
            for (int m = 0; m < 4; ++m) { bf16_t* rowp = O + (size_t)(rowb + ai * HALF + m * 16 + prow) * ldc + col0; const float f = sc * rs[ai][m];
#pragma unroll
                for (int bj = 0; bj < 2; ++bj) { const f32x4 v0 = acc[ai][bj][m][0] * f, v1 = acc[ai][bj][m][1] * f;
                    u32x4 w; w.x = cvt_pk_bf16(v0[0], v0[1]); w.y = cvt_pk_bf16(v0[2], v0[3]); w.z = cvt_pk_bf16(v1[0], v1[1]); w.w = cvt_pk_bf16(v1[2], v1[3]);
                    *(PG8_LAS u32x4*)(st + bj * 1024 + woff) = w; }
#pragma unroll
                for (int bj = 0; bj < 2; ++bj) { const u32x4 p = *(const PG8_LAS u32x4*)(st + bj * 1024 + roff); *(u32x4*)(rowp + bj * HALF) = p; } }
    }
};
struct EpiResid {
    static constexpr bool PERM = true, AFTER_DRAIN = false;
    bf16_t* X; int ldc; float* ssq; PG8_LAS unsigned char* stage;
    __device__ __forceinline__ void operator()(const f32x4 (&acc)[2][2][4][2], const Unit& u, int wr, int wc, int fr, int fq) const {
        const int rowb = u.pm * BM + wr * 64;
        const int lane = fr + 16 * fq; PG8_LAS unsigned char* st = stage + (wr * 4 + wc) * 2048;
        const unsigned woff = (unsigned)(4 * fr + fq) * 16u, roff = (unsigned)lane * 16u;
        const int prow = lane >> 2, col0 = u.pn * BM + wc * 32 + 8 * (lane & 3);
#pragma unroll
        for (int ai = 0; ai < 2; ++ai) {
            u32x4 rva[4][2];
#pragma unroll
            for (int m = 0; m < 4; ++m)
#pragma unroll
                for (int bj = 0; bj < 2; ++bj) rva[m][bj] = *(const u32x4*)(X + (size_t)(rowb + ai * HALF + m * 16 + prow) * ldc + col0 + bj * HALF);
#pragma unroll
            for (int m = 0; m < 4; ++m) { const int row = rowb + ai * HALF + m * 16 + fr; const size_t off = (size_t)(rowb + ai * HALF + m * 16 + prow) * ldc + col0; float q = 0.f;
                u32x4 rv[2];
#pragma unroll
                for (int bj = 0; bj < 2; ++bj) *(PG8_LAS u32x4*)(st + bj * 1024 + roff) = rva[m][bj];
#pragma unroll
                for (int bj = 0; bj < 2; ++bj) rv[bj] = *(const PG8_LAS u32x4*)(st + bj * 1024 + woff);
#pragma unroll
                for (int bj = 0; bj < 2; ++bj) {
                    const f32x4 r0 = {__uint_as_float(rv[bj].x << 16), __uint_as_float(rv[bj].x & 0xffff0000u), __uint_as_float(rv[bj].y << 16), __uint_as_float(rv[bj].y & 0xffff0000u)};
                    const f32x4 r1 = {__uint_as_float(rv[bj].z << 16), __uint_as_float(rv[bj].z & 0xffff0000u), __uint_as_float(rv[bj].w << 16), __uint_as_float(rv[bj].w & 0xffff0000u)};
                    const f32x4 o0 = r0 + acc[ai][bj][m][0], o1 = r1 + acc[ai][bj][m][1];
                    q += ((o0[0] * o0[0] + o0[1] * o0[1]) + (o0[2] * o0[2] + o0[3] * o0[3])) + ((o1[0] * o1[0] + o1[1] * o1[1]) + (o1[2] * o1[2] + o1[3] * o1[3]));
                    u32x4 w; w.x = cvt_pk_bf16(o0[0], o0[1]); w.y = cvt_pk_bf16(o0[2], o0[3]); w.z = cvt_pk_bf16(o1[0], o1[1]); w.w = cvt_pk_bf16(o1[2], o1[3]);
                    *(PG8_LAS u32x4*)(st + bj * 1024 + woff) = w; }
#pragma unroll
                for (int bj = 0; bj < 2; ++bj) { const u32x4 p = *(const PG8_LAS u32x4*)(st + bj * 1024 + roff); *(u32x4*)(X + off + bj * HALF) = p; }
                q += __shfl_xor(q, 16); q += __shfl_xor(q, 32);
                if (fq == 0) ssq[(size_t)row * 16 + u.pn * 4 + wc] = q; }
            asm volatile("" ::: "memory"); }
    }
};
struct EpiKV {
    static constexpr bool PERM = true, AFTER_DRAIN = false;
    bf16_t* KV; const float* b_f; float* logf; const float* ssq; int nslots; PG8_LAS unsigned char* stage;
    __device__ __forceinline__ void operator()(const f32x4 (&acc)[2][2][4][2], const Unit& u, int wr, int wc, int fr, int fq) const {
        const int row0 = u.pm * BM + wr * 64 + fr;
        float rs[2][4]; row_rstd(rs, ssq, nslots, row0);
        if (u.pn < 6) {
            const int col0 = u.pn * BM + wc * 32 + 8 * fq;
#pragma unroll
            for (int ai = 0; ai < 2; ++ai)
#pragma unroll
                for (int m = 0; m < 4; ++m) { bf16_t* rowp = KV + (size_t)(row0 + ai * HALF + m * 16) * 1536 + col0;
#pragma unroll
                    for (int bj = 0; bj < 2; ++bj) { const f32x4 v0 = acc[ai][bj][m][0] * rs[ai][m], v1 = acc[ai][bj][m][1] * rs[ai][m];
                        u32x4 w; w.x = cvt_pk_bf16(v0[0], v0[1]); w.y = cvt_pk_bf16(v0[2], v0[3]); w.z = cvt_pk_bf16(v1[0], v1[1]); w.w = cvt_pk_bf16(v1[2], v1[3]);
                        *(u32x4*)(rowp + bj * HALF) = w; } }
        } else if (wc == 0 && fq < 2) {
#pragma unroll
            for (int ai = 0; ai < 2; ++ai)
#pragma unroll
                for (int m = 0; m < 4; ++m) { const int row = row0 + ai * HALF + m * 16; const int b = row / SEQ, s = row % SEQ;
#pragma unroll
                    for (int n = 0; n < 2; ++n)
#pragma unroll
                        for (int q = 0; q < 4; ++q) { const int col = 8 * fq + 4 * n + q;
                            if (col < FOXH) { const float z = acc[ai][0][m][n][q] * rs[ai][m] + b_f[col]; const float ls = fminf(z, 0.f) - log1pf(expf(-fabsf(z)));
                                logf[((size_t)(b * FOXH + col)) * SEQ + s] = ls; } } }
        }
    }
};
struct MemKvOrder {
    int G, c;
    __device__ bool next(int i, Unit& u) const { const int L = i * G + c; if (L >= 64) return false; const int layer = L >> 4, r = L & 15; u.pm = layer * 8 + (r >> 1); u.pn = layer * 2 + (r & 1); return true; }
    __device__ __forceinline__ void a_ready(const Unit&) const {}
    __device__ __forceinline__ void done(const Unit&) const {}
};


template <class Epi, class Sched, bool ALIGN_EPI = false, bool SP2 = false>
__device__ __forceinline__ void gemm_phase(PG8_LAS unsigned char* lds, const Gemm g, const Sched& S, const Epi& E) {
    int tid_ = threadIdx.x; asm volatile("" : "+v"(tid_));
    const int tid = tid_, wid = __builtin_amdgcn_readfirstlane(tid >> 6), lane = tid & 63, wr = wid >> 2, wc = wid & 3, fr = lane & 15, fq = lane >> 4;
    const int K = g.K, nt = K / BK;
    unsigned voffA[2], voffB[2];
#pragma unroll
    for (int i = 0; i < 2; ++i) { int R, C; stage_rc(tid * 16 + i * 8192, R, C); const int Rb = Epi::PERM ? ((R & ~31) + perm32(R & 31)) : R;
        voffA[i] = (unsigned)(R * K + C) * 2u; voffB[i] = (unsigned)(Rb * K + C) * 2u; }
    const size_t kstep = (size_t)(BK * 2);
    const size_t hstep = (size_t)HALF * K * 2;
    const size_t tstep = 2 * hstep;
    const unsigned ldsw = (unsigned)wid * 1024u;
    const int aoff = lds_byte(wr * 64 + fr, fq * 8), boff = lds_byte(wc * 32 + fr, fq * 8);
#define PG8_SA(b, h) (((b) * 2 + (h)) * HTB)
#define PG8_SB(b, h) ((4 + (b) * 2 + (h)) * HTB)
#define PG8_STAGE(bufoff, gbase, voff) do { _Pragma("unroll") for (int _i = 0; _i < 2; ++_i) \
        __builtin_amdgcn_global_load_lds((const unsigned*)((const char*)(gbase) + (voff)[_i]), (PG8_LAS unsigned*)(lds + (bufoff) + ldsw + _i * 8192), 16, 0, 0); } while (0)
#define PG8_LDA(dst, b, h) do { _Pragma("unroll") for (int m = 0; m < 4; ++m) _Pragma("unroll") for (int k = 0; k < 2; ++k) dst[m][k] = *(const PG8_LAS bf16x8*)(lds + PG8_SA(b, h) + aoff + m * 2048 + k * 1024); } while (0)
#define PG8_LDB(dst, b, h) do { _Pragma("unroll") for (int n = 0; n < 2; ++n) _Pragma("unroll") for (int k = 0; k < 2; ++k) dst[n][k] = *(const PG8_LAS bf16x8*)(lds + PG8_SB(b, h) + boff + n * 2048 + k * 1024); } while (0)
#define PG8_MMA(ai, bj, At, Bt) do { __builtin_amdgcn_s_setprio(1); _Pragma("unroll") for (int m = 0; m < 4; ++m) _Pragma("unroll") for (int n = 0; n < 2; ++n) _Pragma("unroll") for (int k = 0; k < 2; ++k) \
        acc[ai][bj][m][n] = __builtin_amdgcn_mfma_f32_16x16x32_bf16(Bt[n][k], At[m][k], acc[ai][bj][m][n], 0, 0, 0); __builtin_amdgcn_s_setprio(0); } while (0)
#define PG8_WAIT_V(n) asm volatile("s_waitcnt vmcnt(" #n ")" ::: "memory")
#define PG8_WAIT_L(n) asm volatile("s_waitcnt lgkmcnt(" #n ")" ::: "memory")
#define PG8_BAR __builtin_amdgcn_s_barrier()
#define PG8_SCHED __builtin_amdgcn_sched_barrier(0)
    Unit cur, nxt; int ui = 0;
    if (!S.next(0, cur)) return;
    f32x4 acc[2][2][4][2];
#pragma unroll
    for (int a = 0; a < 2; ++a)
#pragma unroll
        for (int b = 0; b < 2; ++b)
#pragma unroll
            for (int m = 0; m < 4; ++m)
#pragma unroll
                for (int n = 0; n < 2; ++n) acc[a][b][m][n] = (f32x4){0.f, 0.f, 0.f, 0.f};
    bf16x8 At[4][2], B0[2][2], B1[2][2];
    const char* cA = (const char*)g.A + (size_t)cur.pm * tstep; const char* cB = (const char*)g.Bt + (size_t)cur.pn * tstep;
    S.a_ready(cur);
    if constexpr (SP2) {
        PG8_STAGE(PG8_SB(0, 0), cB, voffB); PG8_STAGE(PG8_SB(0, 1), cB + hstep, voffB); PG8_STAGE(PG8_SA(0, 0), cA, voffA); PG8_STAGE(PG8_SA(0, 1), cA + hstep, voffA);
        if (wr == 1) PG8_BAR;
        PG8_WAIT_V(2); PG8_BAR;
        PG8_STAGE(PG8_SB(1, 0), cB + kstep, voffB); PG8_STAGE(PG8_SA(1, 0), cA + kstep, voffA); PG8_STAGE(PG8_SB(1, 1), cB + hstep + kstep, voffB);
        PG8_WAIT_V(6); PG8_BAR;
    } else {
        PG8_STAGE(PG8_SB(0, 0), cB, voffB); PG8_STAGE(PG8_SA(0, 0), cA, voffA); PG8_STAGE(PG8_SB(0, 1), cB + hstep, voffB); PG8_STAGE(PG8_SA(0, 1), cA + hstep, voffA);
        if (wr == 1) PG8_BAR;
        PG8_WAIT_V(4); PG8_BAR;
        PG8_STAGE(PG8_SB(1, 0), cB + kstep, voffB); PG8_STAGE(PG8_SA(1, 0), cA + kstep, voffA); PG8_STAGE(PG8_SB(1, 1), cB + hstep + kstep, voffB);
        PG8_WAIT_V(6); PG8_BAR;
    }
    for (;;) {
        const bool has_next = S.next(ui + 1, nxt);
        const char* nA = has_next ? (const char*)g.A + (size_t)nxt.pm * tstep : cA; const char* nB = has_next ? (const char*)g.Bt + (size_t)nxt.pn * tstep : cB;
        for (int t = 0; t < nt; t += 2) {
            const bool last = (t == nt - 2);
            const char* a1 = cA + (size_t)(t + 1) * kstep;
            const char* a2 = last ? nA : cA + (size_t)(t + 2) * kstep; const char* b2 = last ? nB : cB + (size_t)(t + 2) * kstep;
            const char* a3 = a2 + kstep; const char* b3 = b2 + kstep;
            if (last && has_next) S.a_ready(nxt);
            if constexpr (SP2) {
            PG8_LDB(B0, 0, 0); PG8_LDB(B1, 0, 1); PG8_SCHED; PG8_LDA(At, 0, 0); PG8_STAGE(PG8_SA(1, 1), a1 + hstep, voffA);
            PG8_WAIT_V(8); PG8_WAIT_L(0); PG8_BAR; PG8_MMA(0, 0, At, B0); PG8_MMA(0, 1, At, B1); PG8_BAR; PG8_SCHED;
            PG8_LDA(At, 0, 1); PG8_STAGE(PG8_SB(0, 0), b2, voffB); PG8_STAGE(PG8_SB(0, 1), b2 + hstep, voffB); PG8_STAGE(PG8_SA(0, 0), a2, voffA);
            PG8_WAIT_V(8); PG8_WAIT_L(0); PG8_BAR; PG8_MMA(1, 0, At, B0); PG8_MMA(1, 1, At, B1); PG8_BAR; PG8_SCHED;
            PG8_LDB(B0, 1, 0); PG8_LDB(B1, 1, 1); PG8_SCHED; PG8_LDA(At, 1, 0); PG8_STAGE(PG8_SA(0, 1), a2 + hstep, voffA);
            PG8_WAIT_V(8); PG8_WAIT_L(0); PG8_BAR; PG8_MMA(0, 0, At, B0); PG8_MMA(0, 1, At, B1); PG8_BAR; PG8_SCHED;
            PG8_LDA(At, 1, 1); PG8_STAGE(PG8_SB(1, 0), b3, voffB); PG8_STAGE(PG8_SB(1, 1), b3 + hstep, voffB); PG8_STAGE(PG8_SA(1, 0), a3, voffA);
            PG8_WAIT_V(8); PG8_WAIT_L(0); PG8_BAR; PG8_MMA(1, 0, At, B0); PG8_MMA(1, 1, At, B1); PG8_BAR; PG8_SCHED;
            } else {
            PG8_LDB(B0, 0, 0); PG8_SCHED; PG8_LDA(At, 0, 0); PG8_STAGE(PG8_SA(1, 1), a1 + hstep, voffA);
            PG8_WAIT_L(8); PG8_BAR; PG8_WAIT_L(0); PG8_MMA(0, 0, At, B0); PG8_BAR; PG8_SCHED;
            PG8_LDB(B1, 0, 1); PG8_STAGE(PG8_SB(0, 0), b2, voffB);
            PG8_BAR; PG8_WAIT_L(0); PG8_MMA(0, 1, At, B1); PG8_BAR;
            PG8_LDA(At, 0, 1); PG8_STAGE(PG8_SA(0, 0), a2, voffA);
            PG8_BAR; PG8_WAIT_L(0); PG8_MMA(1, 0, At, B0); PG8_BAR; PG8_SCHED;
            PG8_STAGE(PG8_SB(0, 1), b2 + hstep, voffB);
            PG8_WAIT_V(6); PG8_BAR; PG8_MMA(1, 1, At, B1); PG8_BAR;
            PG8_LDB(B0, 1, 0); PG8_SCHED; PG8_LDA(At, 1, 0); PG8_STAGE(PG8_SA(0, 1), a2 + hstep, voffA);
            PG8_WAIT_L(8); PG8_BAR; PG8_WAIT_L(0); PG8_MMA(0, 0, At, B0); PG8_BAR; PG8_SCHED;
            PG8_LDB(B1, 1, 1); PG8_STAGE(PG8_SB(1, 0), b3, voffB);
            PG8_BAR; PG8_WAIT_L(0); PG8_MMA(0, 1, At, B1); PG8_BAR;
            PG8_LDA(At, 1, 1); PG8_STAGE(PG8_SA(1, 0), a3, voffA);
            PG8_BAR; PG8_WAIT_L(0); PG8_MMA(1, 0, At, B0); PG8_BAR; PG8_SCHED;
            PG8_STAGE(PG8_SB(1, 1), b3 + hstep, voffB);
            PG8_WAIT_V(6); PG8_BAR; PG8_MMA(1, 1, At, B1); PG8_BAR;
            }
        }
        if constexpr (ALIGN_EPI) { if (wr == 0) PG8_BAR; }
        if constexpr (!Epi::AFTER_DRAIN) { E(acc, cur, wr, wc, fr, fq); S.done(cur); }
        if (!has_next) break;
#pragma unroll
        for (int a = 0; a < 2; ++a)
#pragma unroll
            for (int b = 0; b < 2; ++b)
#pragma unroll
                for (int m = 0; m < 4; ++m)
#pragma unroll
                    for (int n = 0; n < 2; ++n) acc[a][b][m][n] = (f32x4){0.f, 0.f, 0.f, 0.f};
        cur = nxt; cA = nA; cB = nB; ++ui;
        if constexpr (ALIGN_EPI) { if (wr == 1) PG8_BAR; }
    }
    PG8_WAIT_V(0);
    if constexpr (!ALIGN_EPI) { if (wr == 0) PG8_BAR; }
    PG8_BAR;
    if constexpr (Epi::AFTER_DRAIN) { E.fused(acc, cur, wr, wc, fr, fq, lds, wid, lane); S.done(cur); }
#undef PG8_SA
#undef PG8_SB
#undef PG8_STAGE
#undef PG8_LDA
#undef PG8_LDB
#undef PG8_MMA
#undef PG8_WAIT_V
#undef PG8_WAIT_L
#undef PG8_BAR
#undef PG8_SCHED
}
}
#define GAS __attribute__((address_space(1)))
#define LAS __attribute__((address_space(3)))
typedef unsigned short bf16;
typedef unsigned v4u __attribute__((ext_vector_type(4)));
typedef float f32x4 __attribute__((ext_vector_type(4)));
typedef short bf16x8 __attribute__((ext_vector_type(8)));
typedef GAS unsigned gu32;
typedef GAS unsigned long long gu64;
#define RLX_AGENT __ATOMIC_RELAXED, __HIP_MEMORY_SCOPE_AGENT
#define LDS_WAIT() asm volatile("s_waitcnt lgkmcnt(0)" ::: "memory")
#define VM_WAIT() asm volatile("s_waitcnt vmcnt(0)" ::: "memory")
__device__ __forceinline__ unsigned long long rt() { return __builtin_amdgcn_s_memrealtime(); }
__device__ __forceinline__ unsigned f2bf(float f) { unsigned u = __builtin_bit_cast(unsigned, f); return (u + 0x7fffu + ((u >> 16) & 1u)) >> 16; }
__device__ __forceinline__ unsigned pk2(float lo, float hi) { return f2bf(lo) | (f2bf(hi) << 16); }

#define XB_TMO      128
#define XB_XCNT(j)  (256  + 64 * (j))
#define XB_XSUB(j)  (1280 + 64 * (j))
#define XB_XGEN(j)  (2304 + 64 * (j))
#define XB_TOP      3328
#define XB_TOPGEN   3392
#define XCD_BAR_WORDS 3456
#define XB_SPIN_CAP (1u << 18)

__device__ __forceinline__ unsigned xb_ld(unsigned* p)              { return __hip_atomic_load(p, __ATOMIC_RELAXED, __HIP_MEMORY_SCOPE_AGENT); }
__device__ __forceinline__ unsigned xb_add(unsigned* p, unsigned v) { return __hip_atomic_fetch_add(p, v, __ATOMIC_RELAXED, __HIP_MEMORY_SCOPE_AGENT); }
__device__ __forceinline__ unsigned xb_xcc_id() { return (unsigned)__builtin_amdgcn_s_getreg((3 << 11) | 20) & 0xFu; }
#define XB_SPIN(cond, bar) do { unsigned _sp = 0; while (cond) { __builtin_amdgcn_s_sleep(1); \
    if ((++_sp & 255u) == 0u) { if (xb_ld(&(bar)[XB_TMO])) break; if (_sp > XB_SPIN_CAP) { atomicAdd(&(bar)[XB_TMO], 1u); break; } } } } while (0)

struct XcdBarrier {
    unsigned* bar; unsigned x;
    volatile LAS unsigned* st;
};

__device__ __forceinline__ XcdBarrier xcd_barrier_post(unsigned* bar, volatile LAS unsigned* st) {
    XcdBarrier b; b.bar = bar; b.x = xb_xcc_id(); b.st = st;
    if (threadIdx.x == 0) (void)xb_add(&bar[XB_XCNT(b.x)], 1u);
    return b;
}
__device__ __forceinline__ void xcd_barrier_complete(unsigned* bar, unsigned x, unsigned& nloc, unsigned& nx) {
    const unsigned G = gridDim.x * gridDim.y * gridDim.z;
    unsigned sum, cnt, mine, sp = 0u;
    for (;;) {
        sum = 0u; cnt = 0u; mine = 0u;
#pragma unroll
        for (unsigned j = 0; j < 16; ++j) { const unsigned c = xb_ld(&bar[XB_XCNT(j)]); sum += c; cnt += (c > 0u) ? 1u : 0u; mine = (j == x) ? c : mine; }
        if (sum == G) break;
        __builtin_amdgcn_s_sleep(1);
        if ((++sp & 255u) == 0u) { if (xb_ld(&bar[XB_TMO])) break; if (sp > XB_SPIN_CAP) { atomicAdd(&bar[XB_TMO], 1u); break; } }
    }
    nloc = mine > 0u ? mine : 1u; nx = cnt > 0u ? cnt : 1u;
}

__device__ __forceinline__ void xcd_barrier(const XcdBarrier& b) {
    asm volatile("s_waitcnt vmcnt(0)" ::: "memory");
    __syncthreads();
    if (threadIdx.x == 0) {
        unsigned* bar = b.bar;
        __builtin_amdgcn_s_waitcnt(0);
        unsigned nloc = b.st[0], nx = b.st[1];
        if (nloc == 0u) { xcd_barrier_complete(bar, b.x, nloc, nx); b.st[0] = nloc; b.st[1] = nx; }
        const unsigned old = xb_add(&bar[XB_XSUB(b.x)], 1u);
        const unsigned gen = old / nloc;
        if (old + 1u == (gen + 1u) * nloc) {
            __builtin_amdgcn_fence(__ATOMIC_RELEASE, "agent");
            asm volatile("s_waitcnt vmcnt(0)" ::: "memory");
            const unsigned og = xb_add(&bar[XB_TOP], 1u);
            const unsigned tg = og / nx;
            if (og + 1u == (tg + 1u) * nx) xb_add(&bar[XB_TOPGEN], 1u);
            else XB_SPIN(xb_ld(&bar[XB_TOPGEN]) == tg, bar);
            __builtin_amdgcn_fence(__ATOMIC_ACQUIRE, "agent");
            xb_add(&bar[XB_XGEN(b.x)], 1u);
            asm volatile("s_waitcnt vmcnt(0)" ::: "memory");
        } else {
            XB_SPIN(xb_ld(&bar[XB_XGEN(b.x)]) == gen, bar);
            __builtin_amdgcn_fence(__ATOMIC_ACQUIRE, "agent");
            asm volatile("s_waitcnt vmcnt(0)" ::: "memory");
        }
    }
    __syncthreads();
}

typedef float f32x16 __attribute__((ext_vector_type(16)));
typedef unsigned u32x4 __attribute__((ext_vector_type(4)));
typedef unsigned u32x2 __attribute__((ext_vector_type(2)));
__device__ __forceinline__ float bflo(unsigned u) { return __uint_as_float(u << 16); }
__device__ __forceinline__ float bfhi(unsigned u) { return __uint_as_float(u & 0xffff0000u); }
__device__ __forceinline__ int crow(int r, int hi) { return (r & 3) + 8 * (r >> 2) + 4 * hi; }
__device__ __forceinline__ float wave_sum(float v) {
#pragma unroll
    for (int o = 1; o < 64; o <<= 1) v += __shfl_xor(v, o);
    return v;
}


#include <hip/hip_bf16.h>
#include <cmath>
namespace attn_body {
using bf16=__hip_bfloat16;
using bf16x8=__attribute__((ext_vector_type(8)))short;
using s16x4=__attribute__((ext_vector_type(4)))short;
using f32x16=__attribute__((ext_vector_type(16)))float;
using u32x4=__attribute__((ext_vector_type(4)))unsigned;
constexpr int D=64;
constexpr int NW=8,QBLK=32,QB=QBLK*NW,KVBLK=64;
constexpr int ATTN_UNIT_ROWS=QB;
__device__ __forceinline__ int crow(int r,int hi){return (r&3)+8*(r>>2)+4*hi;}
#define SBAR() __builtin_amdgcn_sched_barrier(0)
__device__ __forceinline__ void cmask(f32x16&p0,f32x16&p1,int jb,int qrel,int hi){
  const float NEG=-INFINITY; int kb=64*jb+4*hi;
  #pragma unroll
  for(int r=0;r<16;++r){int kv=kb+(r&3)+8*(r>>2); if(kv>qrel)p0[r]=NEG; if(kv+32>qrel)p1[r]=NEG;}
}

constexpr int NSLOT=3, SLOTB=8192;
constexpr int LDS_K=0, LDS_V=NSLOT*SLOTB, LDS_WS=2*NSLOT*SLOTB, LDS_OST=LDS_WS+NW*64*4, LDS_CS=LDS_OST+NW*4096, LDS_BYTES=LDS_CS+4096*4;
constexpr float C2=0.125f*1.4426950408889634f;
__device__ __forceinline__ void glds16(const void*gsrc,unsigned lds_dst){unsigned keep;
  asm volatile("s_mov_b32 %0, m0\n\ts_mov_b32 m0, %2\n\ts_nop 0\n\tglobal_load_lds_dwordx4 %1, off\n\ts_mov_b32 m0, %0":"=&s"(keep):"v"(gsrc),"s"(lds_dst):"memory");}
__device__ __forceinline__ float max3f(float a,float b,float c){float r;asm("v_max3_f32 %0, %1, %2, %3":"=v"(r):"v"(a),"v"(b),"v"(c));return r;}
__device__ __forceinline__ float max2f(float a,float b){float r;asm("v_max_f32_e32 %0, %1, %2":"=v"(r):"v"(a),"v"(b));return r;}
__device__ __forceinline__ float fadd_s(float a,float b){float r;asm("v_add_f32_e32 %0, %1, %2":"=v"(r):"v"(a),"v"(b));return r;}
__device__ __forceinline__ float fsub_s(float a,float b){float r;asm("v_sub_f32_e32 %0, %1, %2":"=v"(r):"v"(a),"v"(b));return r;}
typedef float f32x2_t __attribute__((ext_vector_type(2))); typedef __bf16 bf16x2_t __attribute__((ext_vector_type(2))); typedef float f32x4_t __attribute__((ext_vector_type(4)));
__device__ __forceinline__ unsigned cvtpk_s(float lo,float hi){f32x2_t v={lo,hi};bf16x2_t b=__builtin_convertvector(v,bf16x2_t);return __builtin_bit_cast(unsigned,b);}
#define WAIT_BAR(N) asm volatile("s_waitcnt vmcnt(" #N ") lgkmcnt(0)\n\ts_barrier":::"memory")

__device__ __forceinline__ void qkt(f32x16&p0,f32x16&p1,const char*Kslot,const bf16x8*qr,const f32x16&ci0,const f32x16&ci1,int r32,int hi){
  const char*kb=Kslot+hi*1024+r32*16;
  #pragma unroll
  for(int d0=0;d0<4;++d0){
    const bf16x8 b0=*reinterpret_cast<const bf16x8*>(kb+d0*2048);
    const bf16x8 b1=*reinterpret_cast<const bf16x8*>(kb+d0*2048+512);
    if(d0==0){p0=__builtin_amdgcn_mfma_f32_32x32x16_bf16(b0,qr[0],ci0,0,0,0);p1=__builtin_amdgcn_mfma_f32_32x32x16_bf16(b1,qr[0],ci1,0,0,0);}
    else{p0=__builtin_amdgcn_mfma_f32_32x32x16_bf16(b0,qr[d0],p0,0,0,0);p1=__builtin_amdgcn_mfma_f32_32x32x16_bf16(b1,qr[d0],p1,0,0,0);}}
}
typedef __attribute__((address_space(3))) const char* lds_cptr;
typedef short v4i16_t __attribute__((ext_vector_type(4)));
__device__ __forceinline__ void kload8(bf16x8*kf,lds_cptr kp){
  kf[0]=*(const __attribute__((address_space(3))) bf16x8*)(kp);      kf[1]=*(const __attribute__((address_space(3))) bf16x8*)(kp+512);
  kf[2]=*(const __attribute__((address_space(3))) bf16x8*)(kp+2048); kf[3]=*(const __attribute__((address_space(3))) bf16x8*)(kp+2560);
  kf[4]=*(const __attribute__((address_space(3))) bf16x8*)(kp+4096); kf[5]=*(const __attribute__((address_space(3))) bf16x8*)(kp+4608);
  kf[6]=*(const __attribute__((address_space(3))) bf16x8*)(kp+6144); kf[7]=*(const __attribute__((address_space(3))) bf16x8*)(kp+6656);
}
__device__ __forceinline__ void kload2(bf16x8*kf,lds_cptr kp,int j){ kf[2*j]=*(const __attribute__((address_space(3))) bf16x8*)(kp+j*2048); kf[2*j+1]=*(const __attribute__((address_space(3))) bf16x8*)(kp+j*2048+512); }
__device__ __forceinline__ s16x4 vtr(lds_cptr p){ return __builtin_bit_cast(s16x4,__builtin_amdgcn_ds_read_tr16_b64_v4i16((__attribute__((address_space(3))) v4i16_t*)p)); }
__device__ __forceinline__ float rowmax(const f32x16&p0,const f32x16&p1){
  float a=max3f(p0[0],p0[1],p1[0]),b=max3f(p0[2],p0[3],p1[1]);a=max3f(a,p1[2],p1[3]);
  #pragma unroll
  for(int r=4;r<16;r+=4){a=max3f(a,p0[r],p0[r+1]);b=max3f(b,p0[r+2],p0[r+3]);a=max3f(a,p1[r],p1[r+1]);b=max3f(b,p1[r+2],p1[r+3]);}
  const float m=max2f(a,b);
  auto rr=__builtin_amdgcn_permlane32_swap(__float_as_uint(m),__float_as_uint(m),false,false);
  return max2f(__uint_as_float(rr[0]),__uint_as_float(rr[1]));
}
__device__ __forceinline__ void pv(f32x16*o,int vb,bf16x8 pa0,bf16x8 pa1,bf16x8 pa2,bf16x8 pa3){
  #pragma unroll
  for(int d0=0;d0<2;++d0){s16x4 lo[4],hi[4];
    #pragma unroll
    for(int ks=0;ks<4;++ks){
      asm volatile("ds_read_b64_tr_b16 %0,%1 offset:%c2":"=&v"(lo[ks]):"v"(vb),"i"(d0*4096+ks*1024):"memory");
      asm volatile("ds_read_b64_tr_b16 %0,%1 offset:%c2":"=&v"(hi[ks]):"v"(vb),"i"(d0*4096+ks*1024+512):"memory");}
    asm volatile("s_waitcnt lgkmcnt(0)":::"memory");SBAR();
    #define PK(k) (bf16x8){lo[k][0],lo[k][1],lo[k][2],lo[k][3],hi[k][0],hi[k][1],hi[k][2],hi[k][3]}
    o[d0]=__builtin_amdgcn_mfma_f32_32x32x16_bf16(pa0,PK(0),o[d0],0,0,0);
    o[d0]=__builtin_amdgcn_mfma_f32_32x32x16_bf16(pa1,PK(1),o[d0],0,0,0);
    o[d0]=__builtin_amdgcn_mfma_f32_32x32x16_bf16(pa2,PK(2),o[d0],0,0,0);
    o[d0]=__builtin_amdgcn_mfma_f32_32x32x16_bf16(pa3,PK(3),o[d0],0,0,0);
    #undef PK
  }
}

#ifndef ATTN_STORE16
#define ATTN_STORE16(p,v) (*(u32x4*)(p)=(v))
#endif
struct AttnArgs { const bf16* Q; const bf16* K; const bf16* V; bf16* O; const float* cs; int qp, kp, op, q0; float bound; };
template<int THRL,bool FOX> __device__ __forceinline__ void attn_unit(const AttnArgs&A,char*shm){
  int tid_=threadIdx.x; asm volatile("":"+v"(tid_));
  const int tid=tid_,lane=tid&63,r32=lane&31,hi=lane>>5; const int wid=__builtin_amdgcn_readfirstlane(tid>>6);
  const int q0=A.q0; const long qp=A.qp,kp=A.kp,op=A.op;
  const bf16*Qw=A.Q+(long)(wid*QBLK)*qp;
  const bf16*Kh=A.K,*Vh=A.V;
  const unsigned lds0=(unsigned)(uintptr_t)shm;
  float*wsf=(float*)(shm+LDS_WS)+wid*64;
  const bf16*ksrc=Kh+(long)lane*kp+wid*8;
  const bf16*vsrc=Vh+(long)(16*(wid&3)+(lane>>2))*kp+(wid>>2)*32+(lane&3)*8;
  const unsigned kdst=lds0+LDS_K+wid*1024, vdst=lds0+LDS_V+wid*1024;
  #define TILE(s) (FOX ? (((s)<4) ? NT-4+(s) : NT-1-(s)) : (s))
  #define DMA_K(t,slot) glds16(ksrc+(long)TILE(t)*KVBLK*kp,(unsigned)__builtin_amdgcn_readfirstlane(kdst+(slot)))
  #define DMA_V(t,slot) glds16(vsrc+(long)TILE(t)*KVBLK*kp,(unsigned)__builtin_amdgcn_readfirstlane(vdst+(slot)))
  const int vb0=(int)(lds0+LDS_V)+((lane>>4)&1)*32+(lane&3)*8+(4*hi+((lane&15)>>2))*64;
  const char*Kbase=shm+LDS_K; bf16x8 kf[8];
  const lds_cptr shm3=(lds_cptr)shm; const lds_cptr kp0=shm3+LDS_K+hi*1024+r32*16; const lds_cptr vp0=shm3+LDS_V+((lane>>4)&1)*32+(lane&3)*8+(4*hi+((lane&15)>>2))*64;
  const int NT=FOX?(q0+QB)/KVBLK:4;
  float c2q=0.f;
  if(FOX){
    const int n=q0+QB; float*cl=(float*)(shm+LDS_CS);
    for(int i=tid;i<n;i+=NW*64)cl[i]=A.cs[i];
    c2q=A.cs[q0+wid*QBLK+r32]; }
  int NTL=NT;
  if(FOX){ const int a=lane; const bool in=(a<=NT-5); const float bias=in?(A.cs[q0]-A.cs[64*a+63]):0.f;
    const unsigned long long m=__ballot(in&&(2.f*A.bound+bias>=-40.f)); int cnt=__builtin_popcountll(m); cnt+=cnt&1; NTL=4+cnt; if(NTL>NT)NTL=NT; }
  DMA_K(0,0);DMA_V(0,0);DMA_K(1,SLOTB);
  bf16x8 qr[4];
  #pragma unroll
  for(int d0=0;d0<4;++d0)qr[d0]=*reinterpret_cast<const bf16x8*>(&Qw[(long)r32*qp+d0*16+hi*8]);
  float mhat=0.f,l_reg=0.f;f32x16 o[2];o[0]=f32x16{};o[1]=f32x16{};f32x16 negm=f32x16{};asm volatile("":"+v"(negm));
  const int qrel=wid*QBLK+r32;
  #define CMASK(P0,P1,t) do{ if(FOX){ if((t)<4)cmask(P0,P1,(t),qrel,hi); } }while(0)
  float cqm=c2q;
  bool resc=false;
  #define START(P0,P1) do{ const float rm=rowmax(P0,P1); resc=false; \
    { const float dl=rm; mhat=fadd_s(mhat,dl); \
      _Pragma("unroll") for(int r=0;r<16;++r){P0[r]=fsub_s(P0[r],dl);P1[r]=fsub_s(P1[r],dl);} \
      if(FOX){cqm=c2q-mhat;}else{ _Pragma("unroll") for(int r=0;r<16;++r)negm[r]=-mhat; asm volatile("":"+v"(negm)); } } \
    _Pragma("unroll") for(int r=0;r<16;++r)P0[r]=__builtin_amdgcn_exp2f(P0[r]); }while(0)
  #define RESC() do{ if(resc){ asm volatile("s_waitcnt lgkmcnt(0)":::"memory"); \
      _Pragma("unroll") for(int d_=0;d_<2;++d_) _Pragma("unroll") for(int r=0;r<16;++r)o[d_][r]*=wsf[crow(r,hi)]; } }while(0)
  #define CSINIT(C0,C1,s) do{ const __attribute__((address_space(3))) f32x4_t* cp_=(const __attribute__((address_space(3))) f32x4_t*)(shm3+LDS_CS)+(16*TILE(s)+hi); \
    _Pragma("unroll") for(int g_=0;g_<4;++g_){ const f32x4_t a_=cp_[2*g_], b_=cp_[8+2*g_]; \
      C0[4*g_]=cqm-a_[0];C0[4*g_+1]=cqm-a_[1];C0[4*g_+2]=cqm-a_[2];C0[4*g_+3]=cqm-a_[3]; C1[4*g_]=cqm-b_[0];C1[4*g_+1]=cqm-b_[1];C1[4*g_+2]=cqm-b_[2];C1[4*g_+3]=cqm-b_[3]; } }while(0)
  f32x16 pA0,pA1,pB0,pB1;
  int sl_prev=0,sl_cur=0,sl_next=SLOTB;
  #define ROT() do{sl_prev=sl_cur;sl_cur=sl_next;sl_next=(sl_next==(NSLOT-1)*SLOTB)?0:sl_next+SLOTB;}while(0)
  DMA_K(2,2*SLOTB);
  WAIT_BAR(3);
  if(FOX){ f32x16 ci0,ci1; CSINIT(ci0,ci1,0); qkt(pA0,pA1,Kbase,qr,ci0,ci1,r32,hi); } else qkt(pA0,pA1,Kbase,qr,negm,negm,r32,hi);
  asm volatile("s_nop 15\n\ts_nop 7":"+v"(pA0),"+v"(pA1));CMASK(pA0,pA1,0);
  START(pA0,pA1);
  _Pragma("unroll") for(int r=0;r<16;++r)pA1[r]=__builtin_amdgcn_exp2f(pA1[r]);
  WAIT_BAR(0);
  DMA_K(3,0);DMA_V(1,SLOTB);
  ROT();
  kload8(kf,kp0+sl_cur);
  WAIT_BAR(2);
  s16x4 vlo[8],vhi[8]; u32x4 pw0,pw1,pw2,pw3;
  #define PKW(P,B) cvtpk_s(P[B],P[B+1])
  #define PAF(k) __builtin_bit_cast(bf16x8,pw##k)
  #define VFR(i) (bf16x8){vlo[i][0],vlo[i][1],vlo[i][2],vlo[i][3],vhi[i][0],vhi[i][1],vhi[i][2],vhi[i][3]}
  #define PIN(x) asm volatile("":"+v"(x))
  #define MX3(a,b,c) __builtin_fmaxf(__builtin_fmaxf((a),(b)),(c))
  #define GAPA(MF,A0,A1,A2,A3,W0,W1,PW) do{ MF; sacc+=A0; sacc+=A1; sacc+=A2; sacc+=A3; PIN(sacc); W0; W1; PIN(PW); SBAR(); }while(0)
  #define EX(v) __builtin_amdgcn_exp2f(v)
  #define GAPB(MF,X,B) do{ MF; X[B]=EX(X[B]); X[B+1]=EX(X[B+1]); X[B+2]=EX(X[B+2]); X[B+3]=EX(X[B+3]); PIN(X); SBAR(); }while(0)
  #define VRD(i) do{ vlo[i]=vtr(vp_+(((i)>>2)*4096+((i)&3)*1024)); vhi[i]=vtr(vp_+(((i)>>2)*4096+((i)&3)*1024+512)); }while(0)
  #define KRD(G,j) do{ if(G){ kload2(kf,kp0+sl_next,j); SBAR(); } }while(0)
  #define STEP(C0,C1,P0,P1,t,GK,GV,GL) do{ SBAR(); \
    if(FOX){ CSINIT(C0,C1,t); SBAR(); } \
    const lds_cptr vp_=vp0+sl_prev; \
    VRD(0); SBAR(); float sacc=(P0[0]+P0[1]); \
    GAPA(C0=__builtin_amdgcn_mfma_f32_32x32x16_bf16(kf[0],qr[0],FOX?C0:negm,0,0,0), P0[2],P0[3],P0[4],P0[5],     pw0[0]=PKW(P0,0), pw0[1]=PKW(P0,2), pw0); \
    VRD(4); SBAR(); GAPA(C1=__builtin_amdgcn_mfma_f32_32x32x16_bf16(kf[1],qr[0],FOX?C1:negm,0,0,0), P0[6],P0[7],P0[8],P0[9],     pw0[2]=PKW(P0,4), pw0[3]=PKW(P0,6), pw0); \
    VRD(1); SBAR(); GAPA(C0=__builtin_amdgcn_mfma_f32_32x32x16_bf16(kf[2],qr[1],C0,0,0,0),   P0[10],P0[11],P0[12],P0[13], pw1[0]=PKW(P0,8), pw1[1]=PKW(P0,10), pw1); \
    VRD(5); SBAR(); GAPA(C1=__builtin_amdgcn_mfma_f32_32x32x16_bf16(kf[3],qr[1],C1,0,0,0),   P0[14],P0[15],P1[0],P1[1],   pw1[2]=PKW(P0,12),pw1[3]=PKW(P0,14), pw1); \
    VRD(2); SBAR(); GAPA(C0=__builtin_amdgcn_mfma_f32_32x32x16_bf16(kf[4],qr[2],C0,0,0,0),   P1[2],P1[3],P1[4],P1[5],     pw2[0]=PKW(P1,0), pw2[1]=PKW(P1,2), pw2); \
    VRD(6); SBAR(); GAPA(C1=__builtin_amdgcn_mfma_f32_32x32x16_bf16(kf[5],qr[2],C1,0,0,0),   P1[6],P1[7],P1[8],P1[9],     pw2[2]=PKW(P1,4), pw2[3]=PKW(P1,6), pw2); \
    VRD(3); SBAR(); GAPA(C0=__builtin_amdgcn_mfma_f32_32x32x16_bf16(kf[6],qr[3],C0,0,0,0),   P1[10],P1[11],P1[12],P1[13], pw3[0]=PKW(P1,8), pw3[1]=PKW(P1,10), pw3); \
    VRD(7); SBAR(); GAPA(C1=__builtin_amdgcn_mfma_f32_32x32x16_bf16(kf[7],qr[3],C1,0,0,0),   P1[14],P1[15],0.f,0.f,       pw3[2]=PKW(P1,12),pw3[3]=PKW(P1,14), pw3); \
    l_reg+=sacc; \
    if(GK){DMA_K((t)+3,sl_cur);} if(GV){DMA_V((t)+1,sl_next);} \
    CMASK(C0,C1,t); \
    { float a=MX3(C0[0],C0[1],C1[0]),b=MX3(C0[2],C0[3],C1[1]); a=MX3(a,C1[2],C1[3]); \
      _Pragma("unroll") for(int r=4;r<16;r+=4){a=MX3(a,C0[r],C0[r+1]);b=MX3(b,C0[r+2],C0[r+3]);a=MX3(a,C1[r],C1[r+1]);b=MX3(b,C1[r+2],C1[r+3]);} \
      float rm=__builtin_fmaxf(a,b); { auto rr=__builtin_amdgcn_permlane32_swap(__float_as_uint(rm),__float_as_uint(rm),false,false); rm=__builtin_fmaxf(__uint_as_float(rr[0]),__uint_as_float(rr[1])); } \
      resc=false; \
      if(__builtin_expect(__any(rm>(float)THRL),0)){ const float dl=__builtin_fmaxf(rm,0.f); mhat+=dl; \
        _Pragma("unroll") for(int r=0;r<16;++r){C0[r]-=dl;C1[r]-=dl;} \
        if(FOX){cqm-=dl;}else{ _Pragma("unroll") for(int r=0;r<16;++r)negm[r]=-mhat; asm volatile("":"+v"(negm)); } \
        const float f=__builtin_amdgcn_exp2f(-dl); l_reg*=f; if(hi==0)wsf[r32]=f; resc=true; } } \
    SBAR(); \
    GAPB(o[0]=__builtin_amdgcn_mfma_f32_32x32x16_bf16(PAF(0),VFR(0),o[0],0,0,0), C0,0); \
    GAPB(o[1]=__builtin_amdgcn_mfma_f32_32x32x16_bf16(PAF(0),VFR(4),o[1],0,0,0), C0,4); \
    KRD(GL,0); GAPB(o[0]=__builtin_amdgcn_mfma_f32_32x32x16_bf16(PAF(1),VFR(1),o[0],0,0,0), C0,8); \
    KRD(GL,1); GAPB(o[1]=__builtin_amdgcn_mfma_f32_32x32x16_bf16(PAF(1),VFR(5),o[1],0,0,0), C0,12); \
    KRD(GL,2); GAPB(o[0]=__builtin_amdgcn_mfma_f32_32x32x16_bf16(PAF(2),VFR(2),o[0],0,0,0), C1,0); \
    KRD(GL,3); GAPB(o[1]=__builtin_amdgcn_mfma_f32_32x32x16_bf16(PAF(2),VFR(6),o[1],0,0,0), C1,4); \
    GAPB(o[0]=__builtin_amdgcn_mfma_f32_32x32x16_bf16(PAF(3),VFR(3),o[0],0,0,0), C1,8); \
    GAPB(o[1]=__builtin_amdgcn_mfma_f32_32x32x16_bf16(PAF(3),VFR(7),o[1],0,0,0), C1,12); \
    }while(0)
  int t=1;
  if(FOX){ for(;t<5&&t+5<NTL;t+=2){
    STEP(pB0,pB1,pA0,pA1,t,true,true,true);     WAIT_BAR(2); RESC(); ROT();
    STEP(pA0,pA1,pB0,pB1,t+1,true,true,true);   WAIT_BAR(2); RESC(); ROT();
  } }
  #undef CMASK
  #define CMASK(P0,P1,t) do{}while(0)
  for(;t+5<NTL;t+=2){
    STEP(pB0,pB1,pA0,pA1,t,true,true,true);     WAIT_BAR(2); RESC(); ROT();
    STEP(pA0,pA1,pB0,pB1,t+1,true,true,true);   WAIT_BAR(2); RESC(); ROT();
  }
  #undef CMASK
  #define CMASK(P0,P1,t) do{ if(FOX){ if((t)<4)cmask(P0,P1,(t),qrel,hi); } }while(0)
  #define ENDW(tt) do{ if((tt)+3<NTL){WAIT_BAR(2);} else if((tt)+2<NTL){WAIT_BAR(1);} else {WAIT_BAR(0);} }while(0)
  for(;t+1<NTL;t+=2){
    STEP(pB0,pB1,pA0,pA1,t,(t+3<NTL),(t+1<NTL),(t+1<NTL));       ENDW(t);   RESC(); ROT();
    STEP(pA0,pA1,pB0,pB1,t+1,(t+4<NTL),(t+2<NTL),(t+2<NTL));     ENDW(t+1); RESC(); ROT();
  }
  STEP(pB0,pB1,pA0,pA1,NTL-1,false,false,false); RESC();
  { float sacc=pB0[0]+pB0[1]; _Pragma("unroll") for(int r=2;r<16;++r)sacc+=pB0[r]; _Pragma("unroll") for(int r=0;r<16;++r)sacc+=pB1[r]; l_reg+=sacc;
    pw0=(u32x4){PKW(pB0,0),PKW(pB0,2),PKW(pB0,4),PKW(pB0,6)};pw1=(u32x4){PKW(pB0,8),PKW(pB0,10),PKW(pB0,12),PKW(pB0,14)};pw2=(u32x4){PKW(pB1,0),PKW(pB1,2),PKW(pB1,4),PKW(pB1,6)};pw3=(u32x4){PKW(pB1,8),PKW(pB1,10),PKW(pB1,12),PKW(pB1,14)};
    SBAR(); pv(o,vb0+sl_cur,PAF(0),PAF(1),PAF(2),PAF(3)); }
  #undef PKW
  #undef PAF
  #undef VFR
  #undef PIN
  #undef MX3
  #undef GAPA
  #undef GAPB
  #undef EX
  #undef VRD
  #undef KRD
  #undef STEP
  #undef ENDW
  {auto rr=__builtin_amdgcn_permlane32_swap(__float_as_uint(l_reg),__float_as_uint(l_reg),false,false);l_reg=__uint_as_float(rr[0])+__uint_as_float(rr[1]);}
  if(hi==0)wsf[32+r32]=l_reg;asm volatile("s_waitcnt lgkmcnt(0)":::"memory");
  float rli[16];
  #pragma unroll
  for(int r=0;r<16;++r)rli[r]=__builtin_amdgcn_rcpf(wsf[32+crow(r,hi)]);
  bf16*Ow=A.O+(long)(wid*QBLK)*op;
  { bf16*stg=(bf16*)(shm+LDS_OST)+wid*2048;
    #pragma unroll
    for(int r=0;r<16;++r){const int orow=crow(r,hi);
      #pragma unroll
      for(int d0=0;d0<2;++d0)stg[orow*64+d0*32+r32]=__float2bfloat16(o[d0][r]*rli[r]);}
    asm volatile("s_waitcnt lgkmcnt(0)":::"memory");
    #pragma unroll
    for(int i=0;i<4;++i){const int row=i*8+(lane>>3),ch=lane&7; const u32x4 v=*(const u32x4*)(stg+row*64+ch*8); ATTN_STORE16(Ow+(long)row*op+ch*8,v);} }
  asm volatile("s_waitcnt lgkmcnt(0)\n\ts_barrier":::"memory");
  #undef DMA_K
  #undef DMA_V
  #undef TILE
  #undef CSINIT
  #undef CMASK
  #undef START
  #undef RESC
  #undef ROT
}
constexpr int ATTN_LDS_BYTES=LDS_BYTES;
#undef SBAR
#undef WAIT_BAR
}


constexpr size_t MiB = 1u << 20;
constexpr size_t WS_CTL = 0, CTL_ZERO_BYTES = 1 * MiB;
constexpr size_t WS_WINA = 2 * MiB;
constexpr size_t WS_WINB = 12 * MiB;
constexpr size_t WS_WOUT = 16 * MiB;
constexpr size_t WS_WMKV = 24 * MiB;
constexpr size_t WS_WKV = 28 * MiB;
constexpr size_t WS_WPQ = 32 * MiB;
constexpr size_t WS_PKEYS = 48 * MiB;
constexpr size_t WS_MN = 50 * MiB;
constexpr size_t WS_MKV = 66 * MiB;
constexpr size_t WS_LOGF = 74 * MiB;
constexpr size_t WS_C2 = 76 * MiB;
constexpr size_t WS_X = 80 * MiB;
constexpr size_t WS_Z = 208 * MiB;
constexpr size_t WS_PQ = 368 * MiB;
constexpr size_t WS_KV = 496 * MiB;
constexpr size_t WS_YCAT = 592 * MiB;
constexpr size_t WS_IDX = 656 * MiB;
constexpr size_t WS_GATE = 672 * MiB;
constexpr size_t WS_U8 = 688 * MiB;
constexpr size_t WS_V8 = 752 * MiB;
constexpr size_t WS_SU = 816 * MiB;
constexpr size_t WS_SV = 817 * MiB;
constexpr size_t WS_SX = 818 * MiB;
constexpr size_t WS_WSUM = 819 * MiB;
constexpr size_t WS_XQ = 820 * MiB;
constexpr size_t WS_W = 852 * MiB;
constexpr size_t WS_PA = 868 * MiB;
constexpr size_t WS_SSQA = 996 * MiB;
constexpr size_t WS_SSQB = 998 * MiB;
constexpr size_t WS_END = 1000 * MiB;
constexpr int CW_TMO = 0, CW_CODE = 1, CW_BAR = 4096, CW_QM2 = 8192  , CW_KM2 = 8192 + 256  ;

constexpr int PH_PRO = 0, PH_MEMKV = 1, PH_L0 = 2, PH_PER_LAYER = 10, PH_END = PH_L0 + 4 * PH_PER_LAYER;
constexpr int NWAVES = 8;
constexpr int RING_OFF = 0, RING_BYTES = 155648  , LDSCTL_OFF = RING_BYTES, MISC_OFF = LDSCTL_OFF + 320, LDS_BYTES = 156672;


typedef __bf16 bf16x2v __attribute__((ext_vector_type(2)));
__device__ __forceinline__ float dot2bf(unsigned a, unsigned b, float c) { return __builtin_amdgcn_fdot2_f32_bf16(__builtin_bit_cast(bf16x2v, a), __builtin_bit_cast(bf16x2v, b), c, false); }

template <int R> __device__ __forceinline__ void quant_table_rows(const float* const (&src)[R], unsigned char* const (&dst)[R], float* const (&sco)[R], const bool (&ok)[R], int lane);
template <int R> __device__ __forceinline__ void quant_u4_rows(const float* const (&src)[R], unsigned char* const (&dst)[R], float* const (&sco)[R], const bool (&ok)[R], const int (&lowbias)[R], int lane);
__device__ __forceinline__ void tr_item(const float* W, int K, int N, int Npad, bf16* WT, LAS float* scr, int item, int lane, const float* gk = nullptr) {
    const int nblk = Npad / 32, kb = item / nblk, nb = item % nblk, k0 = 64 * kb, n0 = 32 * nb;
    const int nn = n0 + (lane & 31); const bool ok = nn < N;
    float wv[32];
#pragma unroll
    for (int i = 0; i < 32; ++i) { const int kk = 2 * i + (lane >> 5); wv[i] = ok ? __builtin_nontemporal_load(W + (size_t)(k0 + kk) * N + nn) * (gk ? gk[k0 + kk] : 1.f) : 0.f; }
#pragma unroll
    for (int i = 0; i < 32; ++i) { const int kk = 2 * i + (lane >> 5); scr[kk * 33 + (lane & 31)] = wv[i]; }
    LDS_WAIT(); asm volatile("" ::: "memory");
    const int c = lane & 7;
#pragma unroll
    for (int j = 0; j < 4; ++j) { const int n = (lane >> 3) + 8 * j; const LAS float* s = scr + (8 * c) * 33 + n;
        v4u o; o.x = pk2(s[0 * 33], s[1 * 33]); o.y = pk2(s[2 * 33], s[3 * 33]); o.z = pk2(s[4 * 33], s[5 * 33]); o.w = pk2(s[6 * 33], s[7 * 33]);
        *(GAS v4u*)(WT + (size_t)(n0 + n) * K + k0 + 8 * c) = o; }
    LDS_WAIT(); asm volatile("" ::: "memory");
}
__device__ __forceinline__ void norm_row(const float* xrow, const float* g1, bf16* o1, const float* g2, bf16* o2, int lane) {
    const f32x4* xr = (const f32x4*)xrow + lane; f32x4 v[4]; float s = 0.f;
#pragma unroll
    for (int j = 0; j < 4; ++j) { v[j] = xr[64 * j]; s += (v[j].x * v[j].x + v[j].y * v[j].y) + (v[j].z * v[j].z + v[j].w * v[j].w); }
    const float rstd = 1.0f / sqrtf(wave_sum(s) * (1.f / D) + EPS);
#pragma unroll
    for (int j = 0; j < 4; ++j) { const f32x4 g = ((const f32x4*)g1)[64 * j + lane]; const f32x4 y = v[j] * rstd * g;
        u32x2 w; w.x = pk2(y.x, y.y); w.y = pk2(y.z, y.w); ((u32x2*)o1)[64 * j + lane] = w;
        if (o2) { const f32x4 gg = ((const f32x4*)g2)[64 * j + lane]; const f32x4 y2 = v[j] * rstd * gg; u32x2 w2; w2.x = pk2(y2.x, y2.y); w2.y = pk2(y2.z, y2.w); ((u32x2*)o2)[64 * j + lane] = w2; } }
}
__device__ __forceinline__ void cvt_range(const float* src, bf16* dst, size_t n8, size_t gt, size_t ngt) {
    for (size_t i = gt; i < n8; i += ngt) { const f32x4 a = ((const f32x4*)src)[2 * i], b = ((const f32x4*)src)[2 * i + 1];
        u32x4 o; o.x = pk2(a.x, a.y); o.y = pk2(a.z, a.w); o.z = pk2(b.x, b.y); o.w = pk2(b.z, b.w); ((u32x4*)dst)[i] = o; }
}

__device__ __forceinline__ void phase_prologue(const float* const* in, unsigned char* w, LAS unsigned char* ldsp, int tid, int lane, int wave, int G) {
    LAS float* scr = (LAS float*)(ldsp + wave * 16384);
    const int gw = blockIdx.x * NWAVES + wave, NGW = G * NWAVES;
    constexpr int I_INA = (D / 64) * (NA / 32), I_INB = (D / 64) * (NB / 32), I_OUT = (D / 64) * (D / 32), I_MKV = (D / 64) * (512 / 32), I_KV = (D / 64) * (NKVP / 32), I_PQ = (D / 64) * (NPQ / 32);
    constexpr int NITEMS = 2 * I_INA + 2 * I_INB + 4 * I_OUT + 4 * I_MKV + I_KV + 4 * I_PQ;
    for (int it = gw; it < NITEMS; it += NGW) {
        int r = it;
        if (r < 2 * I_INA) { const int l = r / I_INA; tr_item(in[3] + (size_t)l * D * NA, D, NA, NA, (bf16*)(w + WS_WINA) + (size_t)l * NA * D, scr, r % I_INA, lane, in[2] + (size_t)l * D); continue; } r -= 2 * I_INA;
        if (r < 2 * I_INB) { const int l = r / I_INB; tr_item(in[5] + (size_t)l * D * NB, D, NB, NB, (bf16*)(w + WS_WINB) + (size_t)l * NB * D, scr, r % I_INB, lane, in[2] + (size_t)(l + 2) * D); continue; } r -= 2 * I_INB;
        if (r < 4 * I_OUT) { const int l = r / I_OUT; tr_item(in[6] + (size_t)l * D * D, D, D, D, (bf16*)(w + WS_WOUT) + (size_t)l * D * D, scr, r % I_OUT, lane); continue; } r -= 4 * I_OUT;
        if (r < 4 * I_MKV) { const int l = r / I_MKV; tr_item(in[8] + (size_t)l * D * 512, D, 512, 512, (bf16*)(w + WS_WMKV) + (size_t)l * 512 * D, scr, r % I_MKV, lane); continue; } r -= 4 * I_MKV;
        if (r < I_KV) { tr_item(in[10], D, NKV, NKVP, (bf16*)(w + WS_WKV), scr, r, lane, in[9]); continue; } r -= I_KV;
        { const int l = r / I_PQ; tr_item(in[13] + (size_t)l * D * NPQ, D, NPQ, NPQ, (bf16*)(w + WS_WPQ) + (size_t)l * NPQ * D, scr, r % I_PQ, lane, in[12] + (size_t)l * D); }
    }
    const size_t gt = (size_t)blockIdx.x * (NWAVES * 64) + tid, ngt = (size_t)G * NWAVES * 64;
    cvt_range(in[14], (bf16*)(w + WS_PKEYS), (size_t)4 * 8 * 2 * 128 * 128 / 8, gt, ngt);
    for (int r = gw; r < 4 * 2048; r += NGW) { const int l = r >> 11, m = r & 2047; norm_row(in[1] + (size_t)m * D, in[7] + l * D, (bf16*)(w + WS_MN) + (size_t)r * D, nullptr, nullptr, lane); }
    for (int rb = gw; rb < T; rb += 2 * NGW) { f32x4 v[2][4];
#pragma unroll
        for (int u = 0; u < 2; ++u) { const int r = (rb + u * NGW < T) ? rb + u * NGW : rb; const f32x4* xr = (const f32x4*)(in[0] + (size_t)r * D) + lane;
#pragma unroll
            for (int j = 0; j < 4; ++j) v[u][j] = __builtin_nontemporal_load(xr + 64 * j); }
#pragma unroll
        for (int u = 0; u < 2; ++u) { const int r = rb + u * NGW; if (r >= T) continue; float s = 0.f;
#pragma unroll
            for (int j = 0; j < 4; ++j) { s += (v[u][j].x * v[u][j].x + v[u][j].y * v[u][j].y) + (v[u][j].z * v[u][j].z + v[u][j].w * v[u][j].w);
                u32x2 o; o.x = pk2(v[u][j].x, v[u][j].y); o.y = pk2(v[u][j].z, v[u][j].w); ((u32x2*)((bf16*)(w + WS_X) + (size_t)r * D))[64 * j + lane] = o; }
            s = wave_sum(s);
            if (lane < 8) ((float*)(w + WS_SSQB))[(size_t)r * 16 + lane] = (lane == 0) ? s : 0.f; } }
}
__device__ __forceinline__ void phase_norm(const float* x, const float* g, bf16* o, int lane, int wave, int G) {
    const int gw = blockIdx.x * NWAVES + wave, NGW = G * NWAVES;
    for (int r = gw; r < T; r += NGW) norm_row(x + (size_t)r * D, g, o + (size_t)r * D, nullptr, nullptr, lane);
}
__device__ __forceinline__ void phase_conv(const bf16* Z, const float* cw, bf16* Y, int tid, int G) {
    const int nthr = G * NWAVES * 64;
    for (int item = blockIdx.x * (NWAVES * 64) + tid; item < (T / 16) * 96; item += nthr) {
        const int cg8 = item % 96, strip = item / 96; const int t0 = strip * 16, c0 = cg8 * 8;
        float w0[8], w1[8], w2[8], p2[8], p1[8];
#pragma unroll
        for (int i = 0; i < 8; ++i) { w0[i] = cw[c0 + i]; w1[i] = cw[768 + c0 + i]; w2[i] = cw[1536 + c0 + i]; p2[i] = 0.f; p1[i] = 0.f; }
        auto prod = [&](int row, float* p) {
            const u32x4 u = __builtin_nontemporal_load((const u32x4*)(Z + (size_t)row * NA + c0)), c = __builtin_nontemporal_load((const u32x4*)(Z + (size_t)row * NA + 768 + c0));
            p[0] = bflo(u.x) * bflo(c.x); p[1] = bfhi(u.x) * bfhi(c.x); p[2] = bflo(u.y) * bflo(c.y); p[3] = bfhi(u.y) * bfhi(c.y);
            p[4] = bflo(u.z) * bflo(c.z); p[5] = bfhi(u.z) * bfhi(c.z); p[6] = bflo(u.w) * bflo(c.w); p[7] = bfhi(u.w) * bfhi(c.w);
        };
        if ((t0 % SEQ) != 0) { prod(t0 - 2, p2); prod(t0 - 1, p1); }
#pragma unroll 4
        for (int i = 0; i < 16; ++i) {
            const int row = t0 + i; float p0[8]; prod(row, p0);
            const u32x4 bg = __builtin_nontemporal_load((const u32x4*)(Z + (size_t)row * NA + 1536 + c0));
            const float bb[8] = {bflo(bg.x), bfhi(bg.x), bflo(bg.y), bfhi(bg.y), bflo(bg.z), bfhi(bg.z), bflo(bg.w), bfhi(bg.w)};
            float y[8];
#pragma unroll
            for (int q = 0; q < 8; ++q) { y[q] = bb[q] * (w0[q] * p2[q] + w1[q] * p1[q] + w2[q] * p0[q]); p2[q] = p1[q]; p1[q] = p0[q]; }
            u32x4 o; o.x = pk2(y[0], y[1]); o.y = pk2(y[2], y[3]); o.z = pk2(y[4], y[5]); o.w = pk2(y[6], y[7]);
            *(u32x4*)(Y + (size_t)row * D + c0) = o;
        }
    }
}
__device__ __forceinline__ void phase_cumsum(const float* logf, float* c2, int lane, int wave, int G) {
    const int gw = blockIdx.x * NWAVES + wave, NGW = G * NWAVES;
    for (int bh = gw; bh < BATCH * FOXH; bh += NGW) {
        const float* src = logf + (size_t)bh * SEQ + lane * 64; float* dst = c2 + (size_t)bh * SEQ + lane * 64;
        f32x4 v[16]; float s = 0.f;
#pragma unroll
        for (int i = 0; i < 16; ++i) v[i] = ((const f32x4*)src)[i];
#pragma unroll
        for (int i = 0; i < 16; ++i) s += (v[i].x + v[i].y) + (v[i].z + v[i].w);
        float incl = s;
#pragma unroll
        for (int o = 1; o < 64; o <<= 1) { const float t = __shfl_up(incl, o); if (lane >= o) incl += t; }
        float run = incl - s;
#pragma unroll
        for (int i = 0; i < 16; ++i) { f32x4 o; run += v[i].x; o.x = run * LOG2E; run += v[i].y; o.y = run * LOG2E; run += v[i].z; o.z = run * LOG2E; run += v[i].w; o.w = run * LOG2E; ((f32x4*)dst)[i] = o; }
    }
}

__device__ __forceinline__ void quant_table_item(const float* const* in, unsigned char* w, int l, int rb, int NGW, int lane) {
    constexpr int R = 4;
    const float* src[R]; unsigned char* dst[R]; float* sco[R]; bool ok[R]; int lowbias[R];
#pragma unroll
    for (int u = 0; u < R; ++u) { int r = rb + u * NGW; ok[u] = r < 2 * NEXP; if (!ok[u]) r = rb; const int tab = r >> 14, e = r & (NEXP - 1);
        src[u] = in[15 + tab] + ((size_t)l * NEXP + e) * D; dst[u] = (unsigned char*)(w + (tab ? WS_V8 : WS_U8)) + ((size_t)l * 4 * NEXP + e) * 128; sco[u] = (float*)((unsigned short*)(w + WS_SU) + ((size_t)l * NEXP + e) * 2 + tab); lowbias[u] = 8 * tab; }
    quant_u4_rows<R>(src, dst, sco, ok, lowbias, lane);
}


namespace route {
__device__ __forceinline__ int kmax(int a, int b) { int r; asm("v_max_f32 %0, %1, %2" : "=v"(r) : "v"(a), "v"(b)); return r; }
__device__ __forceinline__ int kmin(int a, int b) { int r; asm("v_min_f32 %0, %1, %2" : "=v"(r) : "v"(a), "v"(b)); return r; }
__device__ __forceinline__ void ce(int& a, int& b) { const int mx = kmax(a, b), mn = kmin(a, b); a = mx; b = mn; }
template <int N> __device__ __forceinline__ void clean_desc(int (&v)[N]) {
#pragma unroll
    for (int j = N >> 1; j > 0; j >>= 1)
#pragma unroll
        for (int i = 0; i < N; ++i) { const int l = i ^ j; if (l > i) ce(v[i], v[l]); }
}
template <int N> __device__ __forceinline__ void sort_desc(int (&v)[N]) {
#pragma unroll
    for (int k = 2; k <= N; k <<= 1)
#pragma unroll
        for (int j = k >> 1; j > 0; j >>= 1)
#pragma unroll
            for (int i = 0; i < N; ++i) { const int l = i ^ j; if (l > i) { if ((i & k) == 0) ce(v[i], v[l]); else ce(v[l], v[i]); } }
}
__device__ __forceinline__ void sort16(int (&v)[16]) {
    ce(v[0], v[13]); ce(v[1], v[12]); ce(v[2], v[15]); ce(v[3], v[14]); ce(v[4], v[8]); ce(v[5], v[6]); ce(v[7], v[11]); ce(v[9], v[10]); ce(v[0], v[5]); ce(v[1], v[7]); ce(v[2], v[9]); ce(v[3], v[4]); ce(v[6], v[13]); ce(v[8], v[14]); ce(v[10], v[15]); ce(v[11], v[12]); ce(v[0], v[1]); ce(v[2], v[3]); ce(v[4], v[5]); ce(v[6], v[8]); ce(v[7], v[9]); ce(v[10], v[11]); ce(v[12], v[13]); ce(v[14], v[15]); ce(v[0], v[2]); ce(v[1], v[3]); ce(v[4], v[10]); ce(v[5], v[11]); ce(v[6], v[7]); ce(v[8], v[9]); ce(v[12], v[14]); ce(v[13], v[15]); ce(v[1], v[2]); ce(v[3], v[12]); ce(v[4], v[6]); ce(v[5], v[7]); ce(v[8], v[10]); ce(v[9], v[11]); ce(v[13], v[14]); ce(v[1], v[4]); ce(v[2], v[6]); ce(v[5], v[8]); ce(v[7], v[10]); ce(v[9], v[13]); ce(v[11], v[14]); ce(v[2], v[4]); ce(v[3], v[6]); ce(v[9], v[12]); ce(v[11], v[13]); ce(v[3], v[5]); ce(v[6], v[8]); ce(v[7], v[9]); ce(v[10], v[12]); ce(v[3], v[4]); ce(v[5], v[6]); ce(v[7], v[8]); ce(v[9], v[10]); ce(v[11], v[12]); ce(v[6], v[7]); ce(v[8], v[9]);
}
__device__ __forceinline__ void merge16(int (&a)[16], const int (&b)[16]) {
#pragma unroll
    for (int i = 0; i < 16; ++i) a[i] = kmax(a[i], b[15 - i]);
    clean_desc<16>(a);
}
constexpr int KROW = 272;
constexpr int LDS_KEYS = 0, LDS_TAB = 256 * KROW;
}
__device__ __forceinline__ void route_stage_keys(const bf16* KEYS  , LAS unsigned char* ldsp, int tid) {
    using namespace route;
    const bf16* ksrc = KEYS + (size_t)(blockIdx.x & 7) * 2 * 128 * 128;
    u32x4 kv[8];
#pragma unroll
    for (int i = 0; i < 8; ++i) { const int c = tid + i * NWAVES * 64, row = c >> 4, ch = c & 15; kv[i] = *(const u32x4*)(ksrc + row * 128 + ch * 8); }
#pragma unroll
    for (int i = 0; i < 8; ++i) { const int c = tid + i * NWAVES * 64, row = c >> 4, ch = c & 15; *(LAS u32x4*)(ldsp + LDS_KEYS + row * KROW + ch * 16) = kv[i]; }
}
__device__ __forceinline__ void route_tile(const bf16* PQ, unsigned short* IDX, float* GATE, LAS unsigned char* ldsp, int tile, int lane, int wave) {
    using namespace route;
    const int h = blockIdx.x & 7;
    const int r32 = lane & 31, hi = lane >> 5;
    LAS unsigned char* tab = ldsp + LDS_TAB + wave * 1024;
    {
        const int t = tile * 32 + r32;
        const bf16* qrow = PQ + (size_t)t * NPQ + h * 256 + 8 * hi;
        bf16x8 qq[2][8];
#pragma unroll
        for (int p = 0; p < 2; ++p)
#pragma unroll
            for (int d0 = 0; d0 < 8; ++d0) qq[p][d0] = *(const bf16x8*)(qrow + p * 128 + 16 * d0);
        int P[2][16];
#pragma unroll
        for (int p = 0; p < 2; ++p) {
            f32x16 acc[4];
#pragma unroll
            for (int nb = 0; nb < 4; ++nb)
#pragma unroll
                for (int r = 0; r < 16; ++r) acc[nb][r] = 0.f;
            const LAS unsigned char* kb = ldsp + LDS_KEYS + (p * 128 + r32) * KROW + hi * 16;
#pragma unroll
            for (int d0 = 0; d0 < 8; ++d0)
#pragma unroll
                for (int nb = 0; nb < 4; ++nb) { const bf16x8 kf = *(const LAS bf16x8*)(kb + nb * 32 * KROW + d0 * 32); acc[nb] = __builtin_amdgcn_mfma_f32_32x32x16_bf16(kf, qq[p][d0], acc[nb], 0, 0, 0); }
            int k[4][16];
#pragma unroll
            for (int nb = 0; nb < 4; ++nb)
#pragma unroll
                for (int r = 0; r < 16; ++r) { const int cst = 127 - (32 * nb + (r & 3) + 8 * (r >> 2)); k[nb][r] = (__float_as_int(acc[nb][r]) & ~127) | cst; }
#pragma unroll
            for (int nb = 0; nb < 4; ++nb) sort16(k[nb]);
            merge16(k[0], k[1]); merge16(k[2], k[3]); merge16(k[0], k[2]);
#pragma unroll
            for (int i = 0; i < 16; ++i) P[p][i] = k[0][i] - 4 * hi;
        }
        int OWN[16], OTH[16];
#pragma unroll
        for (int i = 0; i < 16; ++i) { const auto rr = __builtin_amdgcn_permlane32_swap((unsigned)P[0][i], (unsigned)P[1][i], false, false); OWN[i] = (int)rr[0]; OTH[i] = (int)rr[1]; }
        merge16(OWN, OTH);
        { u32x4 tb;
#define TBW(q) (unsigned)((127 - (OWN[4 * q] & 127)) | ((127 - (OWN[4 * q + 1] & 127)) << 8) | ((127 - (OWN[4 * q + 2] & 127)) << 16) | ((127 - (OWN[4 * q + 3] & 127)) << 24))
          tb.x = TBW(0); tb.y = TBW(1); tb.z = TBW(2); tb.w = TBW(3);
#undef TBW
          *(LAS u32x4*)(tab + r32 * 32 + hi * 16) = tb; }
        asm volatile("" ::: "memory");
        float fo[16], ft[16];
#pragma unroll
        for (int i = 0; i < 16; ++i) { const auto rr = __builtin_amdgcn_permlane32_swap((unsigned)OWN[i], (unsigned)OWN[i], false, false); const int oth = hi ? (int)rr[0] : (int)rr[1];
            fo[i] = __int_as_float(OWN[i] & ~127); ft[i] = __int_as_float(oth & ~127); }
        int c[32];
#define CANDV(x, y) ((__float_as_int(fo[x] + ft[y]) & ~255) | (255 - (hi ? (((y) << 4) | (x)) : (((x) << 4) | (y)))))
        c[0] = CANDV(0, 1);
        c[1] = CANDV(0, 2);
        c[2] = CANDV(0, 3);
        c[3] = CANDV(0, 4);
        c[4] = CANDV(0, 5);
        c[5] = CANDV(0, 6);
        c[6] = CANDV(0, 7);
        c[7] = CANDV(0, 8);
        c[8] = CANDV(0, 9);
        c[9] = CANDV(0, 10);
        c[10] = CANDV(0, 11);
        c[11] = CANDV(0, 12);
        c[12] = CANDV(0, 13);
        c[13] = CANDV(0, 14);
        c[14] = CANDV(0, 15);
        c[15] = CANDV(1, 2);
        c[16] = CANDV(1, 3);
        c[17] = CANDV(1, 4);
        c[18] = CANDV(1, 5);
        c[19] = CANDV(1, 6);
        c[20] = CANDV(1, 7);
        c[21] = CANDV(2, 3);
        c[22] = CANDV(2, 4);
        c[23] = hi ? (int)0xFF800000 : CANDV(0, 0);
        c[24] = hi ? (int)0xFF800000 : CANDV(1, 1);
        c[25] = hi ? (int)0xFF800000 : CANDV(2, 2);
        c[26] = hi ? (int)0xFF800000 : CANDV(3, 3);
        c[27] = (int)0xFF800000;
        c[28] = (int)0xFF800000;
        c[29] = (int)0xFF800000;
        c[30] = (int)0xFF800000;
        c[31] = (int)0xFF800000;
#undef CANDV
        int ca[16], cb[16];
#pragma unroll
        for (int i = 0; i < 16; ++i) { ca[i] = c[i]; cb[i] = c[16 + i]; }
        sort16(ca); sort16(cb); merge16(ca, cb);
#pragma unroll
        for (int i = 0; i < 16; ++i) { const auto rr = __builtin_amdgcn_permlane32_swap((unsigned)ca[i], (unsigned)ca[i], false, false); cb[i] = hi ? (int)rr[0] : (int)rr[1]; }
        merge16(ca, cb);
        float ev[16]; float sum = 0.f; const float mx = __int_as_float(ca[0] & ~255);
#pragma unroll
        for (int i = 0; i < 16; ++i) { ev[i] = __expf(__int_as_float(ca[i] & ~255) - mx); sum += ev[i]; }
        const float inv = 1.0f / sum;
        int oi[8]; float og[8]; int him = -hi; asm volatile("" : "+v"(him));
#pragma unroll
        for (int j = 0; j < 8; ++j) { const int key = ca[j] ^ ((ca[j] ^ ca[8 + j]) & him); const float e = __int_as_float(__float_as_int(ev[j]) ^ ((__float_as_int(ev[j]) ^ __float_as_int(ev[8 + j])) & him)); const int code = 255 - (key & 255);
            const int n1 = *(const LAS unsigned char*)(tab + r32 * 32 + (code >> 4)), n2 = *(const LAS unsigned char*)(tab + r32 * 32 + 16 + (code & 15));
            oi[j] = n1 * 128 + n2; og[j] = e * inv; }
        *(u32x4*)(IDX + (size_t)t * 128 + h * 16 + 8 * hi) = (u32x4){(unsigned)oi[0] | ((unsigned)oi[1] << 16), (unsigned)oi[2] | ((unsigned)oi[3] << 16), (unsigned)oi[4] | ((unsigned)oi[5] << 16), (unsigned)oi[6] | ((unsigned)oi[7] << 16)};
        *(u32x4*)((unsigned short*)GATE + (size_t)t * 128 + h * 16 + 8 * hi) = (u32x4){pk2(og[0], og[1]), pk2(og[2], og[3]), pk2(og[4], og[5]), pk2(og[6], og[7])};
        asm volatile("s_waitcnt lgkmcnt(0)" ::: "memory");
    }
}


typedef int v4i __attribute__((ext_vector_type(4)));
typedef int v2i __attribute__((ext_vector_type(2)));
__device__ __forceinline__ v2i tr8_read(unsigned lds_addr) { v2i r; asm volatile("ds_read_b64_tr_b8 %0, %1\n\ts_waitcnt lgkmcnt(0)" : "=&v"(r) : "v"(lds_addr) : "memory"); return r; }
__device__ __forceinline__ unsigned selftest_layouts(LAS unsigned char* tile, int lane) {
    unsigned bad = 0;
    for (int i = lane; i < 16 * 16; i += 64) { const int r = i >> 4, c = i & 15; tile[r * 144 + c] = (unsigned char)((7 * r + 3 * c + 1) & 127); }
    asm volatile("s_waitcnt lgkmcnt(0)" ::: "memory");
    { const int m = lane & 15; const unsigned base = (unsigned)(size_t)tile + (m >> 1) * 144 + 8 * (m & 1);
      const v2i r0 = tr8_read(base), r1 = tr8_read(base + 8 * 144);
#pragma unroll
      for (int p = 0; p < 8; ++p) { const int w0 = (p < 4) ? r0[0] : r0[1], w1 = (p < 4) ? r1[0] : r1[1]; const int b0 = (w0 >> (8 * (p & 3))) & 255, b1 = (w1 >> (8 * (p & 3))) & 255;
          if (b0 != ((7 * p + 3 * m + 1) & 127)) bad |= 1u; if (b1 != ((7 * (p + 8) + 3 * m + 1) & 127)) bad |= 2u; } }
    { const int x = lane & 15, kb = lane >> 4; v4i a, b;
#pragma unroll
      for (int q = 0; q < 4; ++q) { unsigned wa = 0, wb = 0;
#pragma unroll
          for (int e = 0; e < 4; ++e) { const int k = 16 * kb + 4 * q + e; wa |= (unsigned)((((x + 2 * k) % 5) - 2) & 255) << (8 * e); wb |= (unsigned)((((3 * k + x) % 7) - 3) & 255) << (8 * e); }
          a[q] = (int)wa; b[q] = (int)wb; }
      v4i c = {0, 0, 0, 0};
      c = __builtin_amdgcn_mfma_i32_16x16x64_i8(a, b, c, 0, 0, 0);
#pragma unroll
      for (int r = 0; r < 4; ++r) { const int i = 4 * kb + r, j = x; int ref = 0;
          for (int k = 0; k < 64; ++k) ref += (((i + 2 * k) % 5) - 2) * (((3 * k + j) % 7) - 3);
          if (c[r] != ref) bad |= 4u; } }
    return bad;
}


#include <type_traits>
#ifndef VPASS_MFMA
#define VPASS_MFMA 1
#endif
#ifndef W8
#define W8 (VPASS_MFMA ? 0 : 1)
#endif
typedef float f32x2 __attribute__((ext_vector_type(2)));
__device__ __forceinline__ int ired8(int (&p)[8], int lane, int s2, int s1, int s0) {
    { const bool up = (lane & s2) != 0;
#pragma unroll
      for (int j = 0; j < 4; ++j) { const int send = up ? p[j] : p[j + 4], keep = up ? p[j + 4] : p[j]; p[j] = keep + __shfl_xor(send, s2); } }
    { const bool up = (lane & s1) != 0;
#pragma unroll
      for (int j = 0; j < 2; ++j) { const int send = up ? p[j] : p[j + 2], keep = up ? p[j + 2] : p[j]; p[j] = keep + __shfl_xor(send, s1); } }
    { const bool up = (lane & s0) != 0; const int send = up ? p[0] : p[1], keep = up ? p[1] : p[0]; p[0] = keep + __shfl_xor(send, s0); }
    return p[0];
}
__device__ __forceinline__ float wave_sum_dpp(float v) {
    v += __int_as_float(__builtin_amdgcn_update_dpp(0, __float_as_int(v), 0x128, 0xf, 0xf, false));
    v += __int_as_float(__builtin_amdgcn_update_dpp(0, __float_as_int(v), 0x124, 0xf, 0xf, false));
    v += __int_as_float(__builtin_amdgcn_update_dpp(0, __float_as_int(v), 0x122, 0xf, 0xf, false));
    v += __int_as_float(__builtin_amdgcn_update_dpp(0, __float_as_int(v), 0x121, 0xf, 0xf, false));
    const int b = __float_as_int(v);
    return (__int_as_float(__builtin_amdgcn_readlane(b, 0)) + __int_as_float(__builtin_amdgcn_readlane(b, 16))) + (__int_as_float(__builtin_amdgcn_readlane(b, 32)) + __int_as_float(__builtin_amdgcn_readlane(b, 48)));
}
__device__ __forceinline__ float gelu_as(float v) {
    const float t = __builtin_amdgcn_rcpf(fabsf(v) * 0.2316418882f + 1.0f);
    float q = t * 0.5307027145f + (-0.7265760135f); q = q * t + 0.7107068705f; q = q * t + (-0.142248368f); q = q * t + 0.127414796f; q = q * t;
    const float m = v * (q * __builtin_amdgcn_exp2f((v * v) * (-0.72134752044f)));
    return v < 0.f ? m : v - m;
}
__device__ __forceinline__ float wave_max_dpp(float v) {
    v = fmaxf(v, __int_as_float(__builtin_amdgcn_update_dpp(0, __float_as_int(v), 0x128, 0xf, 0xf, false)));
    v = fmaxf(v, __int_as_float(__builtin_amdgcn_update_dpp(0, __float_as_int(v), 0x124, 0xf, 0xf, false)));
    v = fmaxf(v, __int_as_float(__builtin_amdgcn_update_dpp(0, __float_as_int(v), 0x122, 0xf, 0xf, false)));
    v = fmaxf(v, __int_as_float(__builtin_amdgcn_update_dpp(0, __float_as_int(v), 0x121, 0xf, 0xf, false)));
    const int b = __float_as_int(v);
    return fmaxf(fmaxf(__int_as_float(__builtin_amdgcn_readlane(b, 0)), __int_as_float(__builtin_amdgcn_readlane(b, 16))), fmaxf(__int_as_float(__builtin_amdgcn_readlane(b, 32)), __int_as_float(__builtin_amdgcn_readlane(b, 48))));
}
__device__ __forceinline__ float wave_max(float v) {
#pragma unroll
    for (int o = 1; o < 64; o <<= 1) v = fmaxf(v, __shfl_xor(v, o));
    return v;
}
__device__ __forceinline__ unsigned q4(float a, float b, float c, float d, float inv, int off) {
    const int qa = (int)rintf(a * inv) + off, qb = (int)rintf(b * inv) + off, qc = (int)rintf(c * inv) + off, qd = (int)rintf(d * inv) + off;
    return (unsigned)(qa & 255) | ((unsigned)(qb & 255) << 8) | ((unsigned)(qc & 255) << 16) | ((unsigned)(qd & 255) << 24);
}
template <int R> __device__ __forceinline__ void quant_table_rows(const float* const (&src)[R], unsigned char* const (&dst)[R], float* const (&sco)[R], const bool (&ok)[R], int lane) {
    f32x4 v[R][4];
#pragma unroll
    for (int r = 0; r < R; ++r) { const f32x4* p = (const f32x4*)src[r] + lane;
#pragma unroll
        for (int j = 0; j < 4; ++j) v[r][j] = p[64 * j]; }
#pragma unroll
    for (int r = 0; r < R; ++r) {
        float am = 0.f;
#pragma unroll
        for (int j = 0; j < 4; ++j) am = fmaxf(am, fmaxf(fmaxf(fabsf(v[r][j].x), fabsf(v[r][j].y)), fmaxf(fabsf(v[r][j].z), fabsf(v[r][j].w))));
        am = wave_max_dpp(am);
        const float sc = am > 0.f ? am * (1.f / 127.f) : 1.f, inv = 1.f / sc;
        if (ok[r]) {
#pragma unroll
            for (int j = 0; j < 4; ++j)
                *(unsigned*)(dst[r] + (size_t)(2 * j + (lane >> 5)) * ((size_t)NEXP * 128) + ((4 * lane) & 127)) = q4(v[r][j].x, v[r][j].y, v[r][j].z, v[r][j].w, inv, 0);
            if (lane == 0) *sco[r] = sc; }
    }
}
template <int R> __device__ __forceinline__ void quant_u4_rows(const float* const (&src)[R], unsigned char* const (&dst)[R], float* const (&sco)[R], const bool (&ok)[R], const int (&lowbias)[R], int lane) {
    f32x4 v[R][4];
#pragma unroll
    for (int r = 0; r < R; ++r) { const f32x4* p = (const f32x4*)src[r] + lane;
#pragma unroll
        for (int j = 0; j < 4; ++j) v[r][j] = __builtin_nontemporal_load(p + 64 * j); }
#pragma unroll
    for (int r = 0; r < R; ++r) {
        float ss = 0.f;
#pragma unroll
        for (int j = 0; j < 4; ++j) ss += (v[r][j].x * v[r][j].x + v[r][j].y * v[r][j].y) + (v[r][j].z * v[r][j].z + v[r][j].w * v[r][j].w);
        ss = wave_sum_dpp(ss);
        const float rms = sqrtf(ss * (1.f / 1024.f)); const float sc = rms > 0.f ? rms * (2.6f / 7.f) : 1.f, inv = 1.f / sc;
#pragma unroll
        for (int j = 0; j < 4; ++j) {
            unsigned nib = 0;
            { const float f[4] = {v[r][j].x, v[r][j].y, v[r][j].z, v[r][j].w};
              const int bq = lane < 32 ? lowbias[r] : 0;
#pragma unroll
              for (int e = 0; e < 4; ++e) { int q = (int)rintf(f[e] * inv); q = q > 7 ? 7 : (q < -7 ? -7 : q); nib |= (unsigned)((q + bq) & 15) << (8 * e); } }
            const unsigned other = (unsigned)__shfl_xor((int)nib, 32);
            if (ok[r] && lane < 32) *(unsigned*)(dst[r] + (size_t)j * ((size_t)NEXP * 128) + 4 * lane) = nib | (other << 4);
        }
        if (ok[r] && lane == 0) *(unsigned short*)sco[r] = (unsigned short)(pk2(lowbias[r] ? sc * (1.f / 16.f) : sc, 0.f) & 0xffffu);
    }
}
template <int R> __device__ __forceinline__ void quant_x_rows(const bf16* XG, const float* SSQ, const float* gain, unsigned char* XQ, float* SX, const int (&t)[R], const bool (&ok)[R], int lane) {
    const f32x4 gq0 = *(const f32x4*)(gain + 16 * lane), gq1 = *(const f32x4*)(gain + 16 * lane + 4), gq2 = *(const f32x4*)(gain + 16 * lane + 8), gq3 = *(const f32x4*)(gain + 16 * lane + 12);
    const float gq[16] = {gq0[0], gq0[1], gq0[2], gq0[3], gq1[0], gq1[1], gq1[2], gq1[3], gq2[0], gq2[1], gq2[2], gq2[3], gq3[0], gq3[1], gq3[2], gq3[3]};
    u32x4 a[R], b[R]; f32x4 s[R][4];
#pragma unroll
    for (int r = 0; r < R; ++r) { a[r] = *(const u32x4*)(XG + (size_t)t[r] * D + 16 * lane); b[r] = *(const u32x4*)(XG + (size_t)t[r] * D + 16 * lane + 8);
#pragma unroll
        for (int j = 0; j < 4; ++j) s[r][j] = ((const f32x4*)(SSQ + (size_t)t[r] * 16))[j]; }
#pragma unroll
    for (int r = 0; r < R; ++r) {
        const float ssum = (((s[r][0][0] + s[r][0][1]) + (s[r][0][2] + s[r][0][3])) + ((s[r][1][0] + s[r][1][1]) + (s[r][1][2] + s[r][1][3]))) + (((s[r][2][0] + s[r][2][1]) + (s[r][2][2] + s[r][2][3])) + ((s[r][3][0] + s[r][3][1]) + (s[r][3][2] + s[r][3][3])));
        const float rstd = 1.0f / sqrtf(ssum * (1.f / 1024.f) + EPS);
        float f[16] = {bflo(a[r].x), bfhi(a[r].x), bflo(a[r].y), bfhi(a[r].y), bflo(a[r].z), bfhi(a[r].z), bflo(a[r].w), bfhi(a[r].w), bflo(b[r].x), bfhi(b[r].x), bflo(b[r].y), bfhi(b[r].y), bflo(b[r].z), bfhi(b[r].z), bflo(b[r].w), bfhi(b[r].w)};
        float am = 0.f;
#pragma unroll
        for (int i = 0; i < 16; ++i) { f[i] *= rstd * gq[i]; am = fmaxf(am, fabsf(f[i])); }
        am = wave_max_dpp(am);
        const float sc = am > 0.f ? am * (1.f / 119.f) : 1.f, inv = 1.f / sc;
        u32x4 o; o.x = q4(f[0], f[1], f[2], f[3], inv, 0); o.y = q4(f[4], f[5], f[6], f[7], inv, 0); o.z = q4(f[8], f[9], f[10], f[11], inv, 0); o.w = q4(f[12], f[13], f[14], f[15], inv, 0);
        u32x4 da, db;
#pragma unroll
        for (int d = 0; d < 4; ++d) { const unsigned x = o[d];
            const unsigned xb = x & 0x0F0F0F0Fu;
            const unsigned tt = ((x & 0x7F7F7F7Fu) + 0x08080808u) ^ (x & 0x80808080u);
            const unsigned xa = (tt >> 4) & 0x0F0F0F0Fu;
            const unsigned pa = (unsigned)__shfl_xor((int)xa, 8), pb = (unsigned)__shfl_xor((int)xb, 8);
            da[d] = xa | (pa << 4); db[d] = xb | (pb << 4); }
        if (ok[r]) { if ((lane & 8) == 0) { unsigned char* dp = XQ + (size_t)t[r] * D + 256 * (lane >> 4) + 16 * (lane & 7); *(u32x4*)dp = da; *(u32x4*)(dp + 128) = db; } if (lane == 0) SX[t[r]] = sc; }
    }
}
struct USmall { u32x4 xl, xh; u32x4 ia, ib; };
__device__ __forceinline__ void phase_upass(const unsigned char* XQ, const unsigned short* IDX, const unsigned char* U8l  , unsigned* PA  , int lane, int wave, int G) {
    const int nr = G >> 3, cg = blockIdx.x & 3, half = (blockIdx.x >> 2) & 1, rk = blockIdx.x >> 3; if (rk >= nr) return;
    const unsigned char* Us = U8l + (size_t)cg * NEXP * 128;
    const unsigned loff = (lane & 7) * 16;
    const int stride = 2 * nr * NWAVES, tfirst = 2 * (rk * NWAVES + wave) + half, n = (T - tfirst + stride - 1) / stride;
    auto ld_small = [&](int t) { USmall r; const unsigned char* xp = XQ + (size_t)t * D + 256 * cg + (lane & 7) * 16; r.xl = *(const u32x4*)xp; r.xh = *(const u32x4*)(xp + 128);
        const u32x4* ip = (const u32x4*)(IDX + (size_t)t * 128 + (lane >> 3) * 16); r.ia = ip[0]; r.ib = ip[1]; return r; };
    u32x4 R[2][16]; USmall S[2];
#define ROWID(sm, k) ((((k) < 8 ? (sm).ia : (sm).ib)[((k) & 7) >> 1] >> (16 * ((k) & 1))) & 0xffffu)
#define UROWS(dst, sm) _Pragma("unroll") for (int k = 0; k < 16; ++k) { const unsigned row = ROWID(sm, k); dst[k] = *(const u32x4*)(Us + (row * 128u + loff)); }
    if (n <= 0) return;
    S[0] = ld_small(tfirst); UROWS(R[0], S[0]);
    S[1] = ld_small(n > 1 ? tfirst + stride : tfirst);
    auto body = [&](auto PP, int i) {
            constexpr int pp = decltype(PP)::value;
            const int t = tfirst + i * stride;
            const USmall S2 = ld_small(tfirst + ((i + 2 < n) ? i + 2 : n - 1) * stride);
            UROWS(R[pp ^ 1], S[pp ^ 1]);
            const u32x4 xl = S[pp].xl, xh = S[pp].xh;
            int rr[2];
#pragma unroll
            for (int hh = 0; hh < 2; ++hh) {
                int p[8];
#pragma unroll
                for (int k = 0; k < 8; ++k) { const u32x4 u = R[pp][8 * hh + k]; int a1 = 0, a2 = 0;
#pragma unroll
                    for (int d = 0; d < 4; ++d) { a1 = __builtin_amdgcn_sdot8((int)u[d], (int)xl[d], a1, false); a2 = __builtin_amdgcn_sdot8((int)u[d], (int)xh[d], a2, false); }
                    p[k] = (a1 << 4) + a2; }
                rr[hh] = ired8(p, lane, 4, 2, 1);
            }
            PA[((size_t)cg * T + t) * 64 + 8 * (lane & 7) + (lane >> 3)] = pk2((float)rr[0], (float)rr[1]);
            S[pp] = S2;
    };
    for (int it = 0; it < n; it += 2) { body(std::integral_constant<int, 0>{}, it); if (it + 1 < n) body(std::integral_constant<int, 1>{}, it + 1); }
#undef UROWS
}
__device__ __forceinline__ void phase_combine(const unsigned* PA, const unsigned short* IDX, const float* GATE, const float* SX, const unsigned* SUVl  , LAS unsigned char* ldsp, unsigned* WP, float* SW, int lane, int wave, int G) {
    { const int tid = wave * 64 + lane; const u32x4* src = (const u32x4*)SUVl; u32x4 tv[8];
#pragma unroll
      for (int i = 0; i < 8; ++i) tv[i] = src[tid + i * NWAVES * 64];
#pragma unroll
      for (int i = 0; i < 8; ++i) *(LAS u32x4*)(ldsp + (size_t)(tid + i * NWAVES * 64) * 16) = tv[i]; }
    static_assert(NEXP * 4 == 8 * NWAVES * 64 * 16, "the copy above covers exactly the NEXP pair words");
    __syncthreads();
    const int gw = blockIdx.x * NWAVES + wave, NGW = G * NWAVES;
    const int n = (T - gw + NGW - 1) / NGW;
    struct StA { unsigned pa[4]; int i0, i1; float g0, g1, sx; };
    struct StB { float s0, s1, su0, su1, sv0, sv1, g0, g1, sx; };
    const int srcb = 4 * (8 * (lane & 7) + (lane >> 3));
    auto ldA = [&](int k) { const int t = gw + (k < n ? k : n - 1) * NGW; StA r;
#pragma unroll
        for (int s = 0; s < 4; ++s) r.pa[s] = PA[((size_t)s * T + t) * 64 + lane];
        r.i0 = (int)IDX[(size_t)t * 128 + (lane >> 3) * 16 + (lane & 7)]; r.i1 = (int)IDX[(size_t)t * 128 + (lane >> 3) * 16 + 8 + (lane & 7)];
        r.g0 = __uint_as_float((unsigned)((const unsigned short*)GATE)[(size_t)t * 128 + (lane >> 3) * 16 + (lane & 7)] << 16); r.g1 = __uint_as_float((unsigned)((const unsigned short*)GATE)[(size_t)t * 128 + (lane >> 3) * 16 + 8 + (lane & 7)] << 16); r.sx = SX[t]; return r; };
    auto ldB = [&](const StA& a) { StB r; r.s0 = (bflo(a.pa[0]) + bflo(a.pa[1])) + (bflo(a.pa[2]) + bflo(a.pa[3])); r.s1 = (bfhi(a.pa[0]) + bfhi(a.pa[1])) + (bfhi(a.pa[2]) + bfhi(a.pa[3]));
        const int i0 = __builtin_amdgcn_ds_bpermute(srcb, a.i0), i1 = __builtin_amdgcn_ds_bpermute(srcb, a.i1);
        const unsigned p0 = *(const LAS unsigned*)(ldsp + 4 * i0), p1 = *(const LAS unsigned*)(ldsp + 4 * i1); r.su0 = __uint_as_float(p0 << 16); r.sv0 = __uint_as_float(p0 & 0xffff0000u); r.su1 = __uint_as_float(p1 << 16); r.sv1 = __uint_as_float(p1 & 0xffff0000u); r.g0 = __int_as_float(__builtin_amdgcn_ds_bpermute(srcb, __float_as_int(a.g0))); r.g1 = __int_as_float(__builtin_amdgcn_ds_bpermute(srcb, __float_as_int(a.g1))); r.sx = a.sx; return r; };
    if (n <= 0) return;
    StA a1 = ldA(0); StB b0 = ldB(a1); a1 = ldA(1); StA a2 = ldA(2);
    for (int k = 0; k < n; ++k) {
        const int t = gw + k * NGW;
        const StB b1 = ldB(a1);
        const StA a3 = ldA(k + 3);
        {
            const float a0 = b0.s0 * b0.sx * b0.su0, a1v = b0.s1 * b0.sx * b0.su1;
            const float w0 = b0.g0 * gelu_as(a0) * b0.sv0;
            const float w1 = b0.g1 * gelu_as(a1v) * b0.sv1;
            const float am = wave_max_dpp(fmaxf(fabsf(w0), fabsf(w1)));
            const float sw = am > 0.f ? am * (1.f / 127.f) : 1.f, inv = 1.f / sw;
            unsigned char* wb = (unsigned char*)WP + (size_t)t * 256;
            const int f0 = (int)rintf(w0 * inv), f1 = (int)rintf(w1 * inv);
#define QUADPACK(b_) ((unsigned)__builtin_amdgcn_update_dpp(0, (int)(b_), 0x00, 0xf, 0xf, false) | ((unsigned)__builtin_amdgcn_update_dpp(0, (int)(b_), 0x55, 0xf, 0xf, false) << 8) | \
                      ((unsigned)__builtin_amdgcn_update_dpp(0, (int)(b_), 0xAA, 0xf, 0xf, false) << 16) | ((unsigned)__builtin_amdgcn_update_dpp(0, (int)(b_), 0xFF, 0xf, 0xf, false) << 24))
            { const unsigned h0 = QUADPACK((unsigned)(f0 & 255)), h1 = QUADPACK((unsigned)(f1 & 255));
              if ((lane & 3) == 0) { unsigned* wd = (unsigned*)wb + (lane >> 2); wd[0] = h0; wd[16] = h1; } }
#undef QUADPACK
            { const float fs = wave_sum_dpp((float)(f0 + f1)); if (lane == 0) { SW[t] = sw; ((int*)SW)[T + t] = (int)fs; } }
        }
        b0 = b1; a1 = a2; a2 = a3;
    }
}
#if VPASS_MFMA
constexpr int VP_PITCH = 144, VP_TILE = 128 * VP_PITCH, VP_RED_OFF = NWAVES * VP_TILE;
struct VSmall { u32x4 ia, ib; v4i aw[2]; float sw; int ws; u32x2 xv; };
__device__ __forceinline__ void tr8x8_issue(v2i (&r)[8], unsigned a0) {
    asm volatile("ds_read_b64_tr_b8 %0, %8\n\tds_read_b64_tr_b8 %1, %8 offset:1152\n\tds_read_b64_tr_b8 %2, %8 offset:16\n\tds_read_b64_tr_b8 %3, %8 offset:1168\n\t"
                 "ds_read_b64_tr_b8 %4, %8 offset:32\n\tds_read_b64_tr_b8 %5, %8 offset:1184\n\tds_read_b64_tr_b8 %6, %8 offset:48\n\tds_read_b64_tr_b8 %7, %8 offset:1200"
                 : "=&v"(r[0]), "=&v"(r[1]), "=&v"(r[2]), "=&v"(r[3]), "=&v"(r[4]), "=&v"(r[5]), "=&v"(r[6]), "=&v"(r[7]) : "v"(a0) : "memory");
}
#define TR8_WAIT(n, r) asm volatile("s_waitcnt lgkmcnt(" #n ")" : "+v"(r[0]), "+v"(r[1]), "+v"(r[2]), "+v"(r[3]), "+v"(r[4]), "+v"(r[5]), "+v"(r[6]), "+v"(r[7]) :: "memory")
__device__ __forceinline__ void phase_vpass(bf16* x  , const unsigned short* IDX, const unsigned* WP, const float* SW, const unsigned char* V8l,
                                            float* ssq, LAS unsigned char* ldsp, int lane, int wave, int G) {
    const int nr = G >> 3, cg = blockIdx.x & 3, half = (blockIdx.x >> 2) & 1, rk = blockIdx.x >> 3; if (rk >= nr) return;
    const unsigned char* Vs = V8l + (size_t)cg * NEXP * 128;
    const unsigned loff = (lane & 7) * 16;
    const int col = 256 * cg + 4 * lane;
    const int stride = 2 * nr * NWAVES, tfirst = 2 * (rk * NWAVES + wave) + half, n = (T - tfirst + stride - 1) / stride;
    LAS unsigned char* tile = ldsp + wave * VP_TILE; LAS int* red = (LAS int*)(ldsp + VP_RED_OFF + wave * 1024);
    const unsigned wr_off = (unsigned)((lane >> 3) * VP_PITCH + (lane & 7) * 16);
    const unsigned rd_addr = (unsigned)(size_t)tile + (unsigned)((16 * (lane >> 4) + ((lane & 15) >> 1)) * VP_PITCH + 8 * (lane & 1));
    const int ai = lane & 15, akb = lane >> 4;
    auto ld_small = [&](int t) { VSmall r; { const u32x4* ip = (const u32x4*)(IDX + (size_t)t * 128 + (lane >> 3) * 16); r.ia = ip[0]; r.ib = ip[1]; }
        const unsigned char* wb = (const unsigned char*)WP + (size_t)t * 256 + 16 * akb;
        r.aw[0] = *(const v4i*)wb; r.aw[1] = *(const v4i*)(wb + 64);
        if (ai >= 1) { const v4i z = {0, 0, 0, 0}; r.aw[0] = z; r.aw[1] = z; }
        r.sw = SW[t]; r.ws = ((const int*)SW)[T + t]; r.xv = *(const u32x2*)(x + (size_t)t * D + col); return r; };
    u32x4 R[16]; VSmall Sc, Sn;
#define VROWS(dst, sm) _Pragma("unroll") for (int k = 0; k < 16; ++k) { const unsigned row = ROWID(sm, k); dst[k] = *(const u32x4*)(Vs + (row * 128u + loff)); }
    if (n <= 0) return;
    Sc = ld_small(tfirst); VROWS(R, Sc);
    Sn = ld_small(n > 1 ? tfirst + stride : tfirst);
    for (int i = 0; i < n; ++i) {
            const int t = tfirst + i * stride;
            const VSmall S2 = ld_small(tfirst + ((i + 2 < n) ? i + 2 : n - 1) * stride);
#pragma unroll
            for (int k = 0; k < 16; ++k) *(LAS u32x4*)(tile + wr_off + k * 8 * VP_PITCH) = R[k];
            asm volatile("" ::: "memory");
            VROWS(R, Sn);
            v4i al[8], ah[8];
#pragma unroll
            for (int q = 0; q < 8; ++q) { al[q] = (v4i){0, 0, 0, 0}; ah[q] = (v4i){0, 0, 0, 0}; }
            { v2i ra[8], rb[8], rc[8], rd[8];
              const v4i a0 = Sc.aw[0], a1 = Sc.aw[1];
#define MM4(rr, aa, base) _Pragma("unroll") for (int q = 0; q < 4; ++q) { const v4i b_ = {rr[2 * q][0], rr[2 * q][1], rr[2 * q + 1][0], rr[2 * q + 1][1]}; \
                  const v4i bh_ = {(int)((unsigned)b_[0] & 0xF0F0F0F0u), (int)((unsigned)b_[1] & 0xF0F0F0F0u), (int)((unsigned)b_[2] & 0xF0F0F0F0u), (int)((unsigned)b_[3] & 0xF0F0F0F0u)}; \
                  al[base + q] = __builtin_amdgcn_mfma_i32_16x16x64_i8(aa, b_, al[base + q], 0, 0, 0); ah[base + q] = __builtin_amdgcn_mfma_i32_16x16x64_i8(aa, bh_, ah[base + q], 0, 0, 0); }
              tr8x8_issue(ra, rd_addr); tr8x8_issue(rb, rd_addr + 64);
              TR8_WAIT(8, ra); MM4(ra, a0, 0)
              tr8x8_issue(rc, rd_addr + 64 * VP_PITCH);
              TR8_WAIT(8, rb); MM4(rb, a0, 4)
              tr8x8_issue(rd, rd_addr + 64 * VP_PITCH + 64);
              TR8_WAIT(8, rc); MM4(rc, a1, 0)
              TR8_WAIT(0, rd); MM4(rd, a1, 4)
#undef MM4
            }
            if (lane < 16) {
#pragma unroll
                for (int q = 0; q < 8; ++q) { const int hv = ah[q][0]; red[16 * q + lane] = al[q][0] - hv; red[128 + 16 * q + lane] = hv; } }
            asm volatile("s_waitcnt lgkmcnt(0)" ::: "memory");
            v4i o4 = *(const LAS v4i*)(red + 4 * lane);
            if (lane < 32) { const int c8 = 8 * Sc.ws; o4[0] = (o4[0] - c8) * 16; o4[1] = (o4[1] - c8) * 16; o4[2] = (o4[2] - c8) * 16; o4[3] = (o4[3] - c8) * 16; }
            const float sw = Sc.sw;
            const float x0 = bflo(Sc.xv.x) + sw * (float)o4[0], x1 = bfhi(Sc.xv.x) + sw * (float)o4[1], x2 = bflo(Sc.xv.y) + sw * (float)o4[2], x3 = bfhi(Sc.xv.y) + sw * (float)o4[3];
            *(u32x2*)(x + (size_t)t * D + col) = (u32x2){pk2(x0, x1), pk2(x2, x3)};
            { const float qs = wave_sum_dpp((x0 * x0 + x1 * x1) + (x2 * x2 + x3 * x3)); if (lane == 0) ssq[(size_t)t * 16 + cg] = qs; }
            Sc = Sn; Sn = S2;
    }
#undef VROWS
}
#endif
__device__ __forceinline__ void phase_final_norm(const bf16* X, const float* ssq, const float* g, float* out, int lane, int wave, int G) {
    const int gw = blockIdx.x * NWAVES + wave, NGW = G * NWAVES;
    constexpr int R = 4;
    f32x4 gv[4];
#pragma unroll
    for (int j = 0; j < 4; ++j) gv[j] = ((const f32x4*)g)[64 * j + lane];
    for (int rb = gw; rb < T; rb += R * NGW) {
        u32x2 v[R][4]; f32x4 s0[R], s1[R];
#pragma unroll
        for (int u = 0; u < R; ++u) { const int r = (rb + u * NGW < T) ? rb + u * NGW : rb; const u32x2* xr = (const u32x2*)(X + (size_t)r * D) + lane;
#pragma unroll
            for (int j = 0; j < 4; ++j) v[u][j] = xr[64 * j];
            s0[u] = ((const f32x4*)(ssq + (size_t)r * 16))[0]; s1[u] = ((const f32x4*)(ssq + (size_t)r * 16))[1]; }
#pragma unroll
        for (int u = 0; u < R; ++u) { const int r = rb + u * NGW; if (r >= T) continue; f32x4* orow = (f32x4*)(out + (size_t)r * D) + lane;
            const float ss = ((s0[u][0] + s0[u][1]) + (s0[u][2] + s0[u][3])) + ((s1[u][0] + s1[u][1]) + (s1[u][2] + s1[u][3]));
            const float rstd = 1.0f / sqrtf(ss * (1.f / D) + EPS);
#pragma unroll
            for (int j = 0; j < 4; ++j) { const f32x4 xv = {bflo(v[u][j].x), bfhi(v[u][j].x), bflo(v[u][j].y), bfhi(v[u][j].y)}; __builtin_nontemporal_store(xv * rstd * gv[j], orow + 64 * j); } }
    }
}


__device__ __forceinline__ void phase_attn_mem(const bf16* Zq, int qp, int qcol, const bf16* MKVl, bf16* YC, char* lds, int vcu, int G) {
    for (int u = vcu; u < BATCH * MEMH * 16; u += G) {
        const int bh = u >> 4, qb = u & 15; const int b = bh >> 2, h = bh & 3;
        attn_body::AttnArgs A;
        A.Q = (const attn_body::bf16*)(Zq + ((size_t)b * SEQ + qb * 256) * qp + qcol + h * 64);
        A.K = (const attn_body::bf16*)(MKVl + (size_t)b * NMEM * 512 + h * 64); A.V = A.K + 256;
        A.O = (attn_body::bf16*)(YC + ((size_t)b * SEQ + qb * 256) * D + 768 + h * 64);
        A.cs = nullptr; A.qp = qp; A.kp = 512; A.op = D; A.q0 = qb * 256; A.bound = 0.f;
        attn_body::attn_unit<8, false>(A, lds);
    }
}
__device__ __forceinline__ void phase_headnorm_max(const bf16* X, int pitch, unsigned* out, int lane, int wave, int G) {
    const int gw = blockIdx.x * NWAVES + wave, NGW = G * NWAVES;
    for (int task = gw; task < BATCH * FOXH * 16; task += NGW) {
        const int bh = task >> 4, ch = task & 15; const int b = bh / FOXH, h = bh % FOXH; float mx = 0.f;
        const bf16* rp0 = X + ((size_t)b * SEQ + ch * 256 + (lane >> 3)) * pitch + h * 64 + 8 * (lane & 7);
#pragma unroll 16
        for (int i = 0; i < 32; ++i) { const u32x4 v = *(const u32x4*)(rp0 + (size_t)(8 * i) * pitch);
            float ss = bflo(v.x) * bflo(v.x) + bfhi(v.x) * bfhi(v.x) + bflo(v.y) * bflo(v.y) + bfhi(v.y) * bfhi(v.y) + bflo(v.z) * bflo(v.z) + bfhi(v.z) * bfhi(v.z) + bflo(v.w) * bflo(v.w) + bfhi(v.w) * bfhi(v.w);
            ss += __shfl_xor(ss, 1); ss += __shfl_xor(ss, 2); ss += __shfl_xor(ss, 4);
            mx = fmaxf(mx, ss); }
        mx = wave_max(mx);
        if (lane == 0) atomicMax(out + bh, __float_as_uint(mx));
    }
}
__device__ __forceinline__ void phase_attn_fox(const bf16* Zq, const bf16* KVb, const float* C2v, const unsigned* QM2, const unsigned* KM2, bf16* YC, char* lds, int vcu, int G) {
    for (int p = vcu; p < BATCH * FOXH * 8; p += G) {
        const int bh = p >> 3, s = p & 7; const int b = bh / FOXH, h = bh % FOXH;
        const float bound = sqrtf(__uint_as_float(QM2[bh]) * __uint_as_float(KM2[bh])) * 1.001f + 0.01f;
#pragma nounroll
        for (int k = 0; k < 2; ++k) {
            const int qb = k ? 15 - s : s;
            attn_body::AttnArgs A;
            A.Q = (const attn_body::bf16*)(Zq + ((size_t)b * SEQ + qb * 256) * NB + h * 64);
            A.K = (const attn_body::bf16*)(KVb + (size_t)b * SEQ * 1536 + h * 64); A.V = A.K + 768;
            A.O = (attn_body::bf16*)(YC + ((size_t)b * SEQ + qb * 256) * D + h * 64);
            A.cs = C2v + (size_t)bh * SEQ; A.qp = NB; A.kp = 1536; A.op = D; A.q0 = qb * 256; A.bound = bound;
            attn_body::attn_unit<8, true>(A, lds);
        }
    }
}


#ifndef SELFTEST
#define SELFTEST 0
#endif
#ifndef PROBE_K
#define PROBE_K -99
#endif
#ifndef PROBE_T
#define PROBE_T -99
#endif
#ifndef PROBE_L
#define PROBE_L -1
#endif
#ifndef PROBE_SKEW
#define PROBE_SKEW 0
#endif
#ifndef ROUTE_WAVES
#define ROUTE_WAVES 6
#endif
#ifndef PROBE_MODE
#define PROBE_MODE 0
#endif
#ifndef PROBE_N
#define PROBE_N 1
#endif
#define REPS(k) for (int rep_ = 0; rep_ < ((k) == PROBE_K ? 1 + PROBE_N : 1); ++rep_)
#ifndef SITES
#define SITES 0xFFFF
#endif
struct Args { const float* in[18]; float* out; unsigned char* ws; int ph_lo, ph_hi, use_bar, pad; };
__global__ void __launch_bounds__(NWAVES * 64, 2) mk_fwd(Args args) {
    extern __shared__ __attribute__((aligned(16))) unsigned char lds[];
    LAS unsigned char* const ldsp = (LAS unsigned char*)lds;
    volatile LAS unsigned* const MISC = (volatile LAS unsigned*)(ldsp + MISC_OFF);
    const int tid = threadIdx.x; const int G = gridDim.x; const int lane = tid & 63; const int wave = __builtin_amdgcn_readfirstlane(tid >> 6);
    gu32* const ctl = (gu32*)(args.ws + WS_CTL);
    for (int u = tid; u < (LDS_BYTES - LDSCTL_OFF) / 4; u += NWAVES * 64) ((LAS unsigned*)(ldsp + LDSCTL_OFF))[u] = 0u;
    __syncthreads();
    XcdBarrier bar; bar.bar = (unsigned*)(ctl + CW_BAR); bar.x = 0; bar.st = nullptr;
    if (args.use_bar) bar = xcd_barrier_post((unsigned*)(ctl + CW_BAR), MISC + 8);
    const int lo = args.ph_lo, hi = args.ph_hi;
#define IN(k) (lo <= (k) && (k) < hi)
    int curL_ = -1;
    volatile LAS unsigned long long* const tw_ = (volatile LAS unsigned long long*)(ldsp + MISC_OFF + 64);
    if (PROBE_T != -99 && blockIdx.x == 0 && threadIdx.x == 0) { tw_[0] = 0ull; tw_[1] = __builtin_amdgcn_s_memrealtime(); }
#define PHID(k) ((k) < PH_L0 ? 100 + (k) : ((k) - PH_L0) % PH_PER_LAYER)
#define TICK(id) do { if (PROBE_T != -99 && blockIdx.x == 0 && threadIdx.x == 0) { const unsigned long long now_ = __builtin_amdgcn_s_memrealtime(); if (!PROBE_SKEW && (id) == PROBE_T && (PROBE_L < 0 || curL_ == PROBE_L)) tw_[0] += now_ - tw_[1]; tw_[1] = now_; } } while (0)
#define ARRIVE(id) do { if (PROBE_SKEW && PROBE_T != -99 && (id) == PROBE_T && (PROBE_L < 0 || curL_ == PROBE_L) && threadIdx.x == 0) ((unsigned long long*)(ctl + 32768))[blockIdx.x] = __builtin_amdgcn_s_memrealtime(); } while (0)
#define SKEW(id) do { if (PROBE_SKEW && PROBE_T != -99 && (id) == PROBE_T && (PROBE_L < 0 || curL_ == PROBE_L) && blockIdx.x == 0 && threadIdx.x == 0) { unsigned long long mx_ = 0ull, sm_ = 0ull; \
    for (int q_ = 0; q_ < G; ++q_) { const unsigned long long s_ = __hip_atomic_load((unsigned long long*)(ctl + 32768) + q_, RLX_AGENT); mx_ = s_ > mx_ ? s_ : mx_; sm_ += s_; } tw_[0] += mx_ - sm_ / (unsigned long long)G; } } while (0)
#define SEAM(k) do { if (IN(k) && IN((k) + 1)) { ARRIVE(PHID(k)); xcd_barrier(bar); SKEW(PHID(k)); TICK(PHID(k)); } } while (0)
#define FRESH_WS(w) GAS unsigned char* w##_g = (GAS unsigned char*)args.ws; asm volatile("" : "+s"(w##_g)); unsigned char* const w = (unsigned char*)w##_g
#define FRESH_INT(v, e) int v = (e); asm volatile("" : "+s"(v))
#define FRESH_TID(t, ln, wv) int t = threadIdx.x; asm volatile("" : "+v"(t)); const int ln = t & 63; const int wv = __builtin_amdgcn_readfirstlane(t >> 6)

#if SELFTEST
    if (IN(PH_PRO) && blockIdx.x == 0) { FRESH_TID(t_, l_, w_); if (w_ == 0) { const unsigned bad = selftest_layouts(ldsp, l_); if (bad & SELFTEST) atomicOr((unsigned*)(ctl + CW_CODE), bad); } }
    __syncthreads();
#endif
    if ((SITES & 64) && IN(PH_PRO)) { FRESH_WS(w); FRESH_TID(t_, l_, w_); phase_prologue(args.in, w, ldsp, t_, l_, w_, G); }
    SEAM(PH_PRO);
    if ((SITES & 1) && IN(PH_MEMKV)) {
        FRESH_WS(w);
        pg8::Gemm g{(bf16*)(w + WS_MN), (bf16*)(w + WS_WMKV), 4 * 2048, 4 * 512, D}; pg8::MemKvOrder S{G, (int)blockIdx.x};
        pg8::EpiStore E{(bf16*)(w + WS_MKV), 512, 512, 1 << 30, 1.f};
        E.stage = (PG8_LAS unsigned char*)(ldsp + RING_OFF + pg8::STAGE_BYTES);
        pg8::gemm_phase<pg8::EpiStore, pg8::MemKvOrder, true, true>(ldsp + RING_OFF, g, S, E);
    }
    SEAM(PH_MEMKV);
    for (int L = 0; L < 4; ++L) {
        const int pb = PH_L0 + PH_PER_LAYER * L; if (PROBE_T != -99) curL_ = L;
        REPS(0) if (IN(pb + 0)) {
            if ((SITES & 2) && L < 2) {
                FRESH_WS(w); FRESH_INT(l, L);
                pg8::Gemm g{(bf16*)(w + WS_X), (bf16*)(w + WS_WINA) + (size_t)l * NA * D, T, NA, D}; pg8::StaticOrder S; S.init(T, NA, G, (int)blockIdx.x);
                pg8::EpiStore E{(bf16*)(w + WS_Z), NA, 1 << 30, 2304, C2, (const float*)(w + WS_SSQB), 8};
                E.stage = (PG8_LAS unsigned char*)(ldsp + RING_OFF + pg8::STAGE_BYTES);
                pg8::gemm_phase<pg8::EpiStore, pg8::StaticOrder, true, true>(ldsp + RING_OFF, g, S, E);
            } else if (L >= 2) {
                if ((SITES & 4) && L == 2) {
                    FRESH_WS(w);
                    pg8::Gemm g{(bf16*)(w + WS_X), (bf16*)(w + WS_WKV), T, NKVP, D}; pg8::StaticOrder S; S.init(T, NKVP, G, (int)blockIdx.x);
                    pg8::EpiKV E{(bf16*)(w + WS_KV), args.in[11], (float*)(w + WS_LOGF), (const float*)(w + WS_SSQB), 8};
                    E.stage = (PG8_LAS unsigned char*)(ldsp + RING_OFF + pg8::STAGE_BYTES);
                    pg8::gemm_phase<pg8::EpiKV, pg8::StaticOrder, true, true>(ldsp + RING_OFF, g, S, E);
                    __syncthreads();
                }
                if (SITES & 8) {
                FRESH_WS(w); FRESH_INT(l, L - 2);
                pg8::Gemm g{(bf16*)(w + WS_X), (bf16*)(w + WS_WINB) + (size_t)l * NB * D, T, NB, D}; pg8::StaticOrder S; S.init(T, NB, G, (int)blockIdx.x);
                pg8::EpiStore E{(bf16*)(w + WS_Z), NB, 1 << 30, 0, C2, (const float*)(w + WS_SSQB), 8};
                E.stage = (PG8_LAS unsigned char*)(ldsp + RING_OFF + pg8::STAGE_BYTES);
                pg8::gemm_phase<pg8::EpiStore, pg8::StaticOrder, true, true>(ldsp + RING_OFF, g, S, E);
                }
            }
        }
        if (PROBE_K == 0 && IN(pb + 0) && L < 2) { __syncthreads();
                FRESH_WS(w); const int l = L;
                pg8::Gemm g{(bf16*)(w + WS_X), (bf16*)(w + WS_WINA) + (size_t)l * NA * D, T, NA, D}; pg8::StaticOrder S; S.init(T, NA, G, (int)blockIdx.x);
                pg8::EpiStore E{(bf16*)(w + WS_Z), NA, 1 << 30, 2304, C2, (const float*)(w + WS_SSQB), 8};
                E.stage = (PG8_LAS unsigned char*)(ldsp + RING_OFF + pg8::STAGE_BYTES);
                pg8::gemm_phase<pg8::EpiStore, pg8::StaticOrder, true, true>(ldsp + RING_OFF, g, S, E); }
        if (L >= 2) SEAM(pb + 0); else { if (IN(pb + 0) && IN(pb + 2)) { ARRIVE(0); xcd_barrier(bar); SKEW(0); TICK(0); } }
        if ((SITES & 128) && IN(pb + 1) && L >= 2) { FRESH_WS(w); FRESH_INT(l, L); FRESH_TID(t_, l_, w_);
            if (l == 2) { phase_cumsum((const float*)(w + WS_LOGF), (float*)(w + WS_C2), l_, w_, G); phase_headnorm_max((const bf16*)(w + WS_KV), 1536, (unsigned*)(ctl + CW_KM2), l_, w_, G); }
            phase_headnorm_max((const bf16*)(w + WS_Z), NB, (unsigned*)(ctl + CW_QM2) + (l - 2) * 128, l_, w_, G); }
        if (L >= 2) SEAM(pb + 1);
        REPS(2) if (IN(pb + 2)) {
            if (SITES & 4096) { FRESH_WS(w); FRESH_INT(l, L); const int vcu = (G % 8 == 0) ? ((int)blockIdx.x % 8) * (G / 8) + (int)blockIdx.x / 8 : (int)blockIdx.x;
                phase_attn_mem((const bf16*)(w + WS_Z), (l < 2) ? NA : NB, (l < 2) ? 2304 : 768, (const bf16*)(w + WS_MKV) + (size_t)l * 2048 * 512, (bf16*)(w + WS_YCAT), (char*)lds, vcu, G); }
            if ((SITES & 8192) && L >= 2) { FRESH_WS(w); const int vcu = (G % 8 == 0) ? ((int)blockIdx.x % 8) * (G / 8) + (int)blockIdx.x / 8 : (int)blockIdx.x;
                phase_attn_fox((const bf16*)(w + WS_Z), (const bf16*)(w + WS_KV), (const float*)(w + WS_C2), (const unsigned*)(ctl + CW_QM2) + (L - 2) * 128, (const unsigned*)(ctl + CW_KM2), (bf16*)(w + WS_YCAT), (char*)lds, vcu, G); }
            if ((SITES & 256) && L < 2) { FRESH_WS(w); FRESH_INT(l, L); FRESH_TID(t_, l_, w_); phase_conv((const bf16*)(w + WS_Z), args.in[4] + (size_t)l * 3 * 768, (bf16*)(w + WS_YCAT), t_, G); }
        }
        SEAM(pb + 2);
        if (PROBE_K == 20 && args.use_bar) { for (int q = 0; q < 10; ++q) xcd_barrier(bar); }
        if ((SITES & 16) && IN(pb + 3)) {
            FRESH_WS(w); FRESH_INT(l, L);
            pg8::Gemm g{(bf16*)(w + WS_YCAT), (bf16*)(w + WS_WOUT) + (size_t)l * D * D, T, D, D}; pg8::StaticOrder S; S.init(T, D, G, (int)blockIdx.x);
            pg8::EpiResid E{(bf16*)(w + WS_X), D, (float*)(w + WS_SSQA)};
            E.stage = (PG8_LAS unsigned char*)(ldsp + RING_OFF + pg8::STAGE_BYTES);
            pg8::gemm_phase<pg8::EpiResid, pg8::StaticOrder, true, true>(ldsp + RING_OFF, g, S, E);
        }
        if (PROBE_K == 3 && IN(pb + 3)) { __syncthreads();
            FRESH_WS(w); FRESH_INT(l, L);
            pg8::Gemm g{(bf16*)(w + WS_YCAT), (bf16*)(w + WS_WOUT) + (size_t)l * D * D, T, D, D}; pg8::StaticOrder S; S.init(T, D, G, (int)blockIdx.x);
            pg8::EpiResid E{(bf16*)(w + WS_PQ), D, (float*)(w + WS_SSQB)};
            E.stage = (PG8_LAS unsigned char*)(ldsp + RING_OFF + pg8::STAGE_BYTES);
            pg8::gemm_phase<pg8::EpiResid, pg8::StaticOrder, true, true>(ldsp + RING_OFF, g, S, E); }
        SEAM(pb + 3);
        REPS(4) if ((SITES & 32) && IN(pb + 4)) {
            FRESH_WS(w); FRESH_INT(l, L);
            pg8::Gemm g{(bf16*)(w + WS_X), (bf16*)(w + WS_WPQ) + (size_t)l * NPQ * D, T, NPQ, D}; pg8::StaticOrder S; S.init(T, NPQ, G, (int)blockIdx.x);
            pg8::EpiStore E{(bf16*)(w + WS_PQ), NPQ, 1 << 30, 1 << 30, 1.f, (const float*)(w + WS_SSQA), 16};
            E.stage = (PG8_LAS unsigned char*)(ldsp + RING_OFF + pg8::STAGE_BYTES);
            pg8::gemm_phase<pg8::EpiStore, pg8::StaticOrder, true, true>(ldsp + RING_OFF, g, S, E);
        }
        SEAM(pb + 4);
        REPS(5) if ((SITES & 1024) && IN(pb + 5)) { FRESH_WS(w); FRESH_INT(l, L); FRESH_TID(t_, l_, w_);
            static_assert(T == 2 * NEXP, "the row items are numbered for equally many table and activation rows");
            LAS int* const wq = (LAS int*)(ldsp + MISC_OFF + 128);
            if (t_ == 0) { int z_ = 0; asm volatile("" : "+v"(z_)); wq[0] = z_; wq[1] = z_; }
            route_stage_keys((const bf16*)(w + WS_PKEYS) + (size_t)l * 8 * 2 * 128 * 128, ldsp, t_);
            __syncthreads();
            const int nb8 = G >> 3, grp = (int)blockIdx.x >> 3, NGW_ = G * NWAVES;
            int mode = (w_ < ROUTE_WAVES) ? 0 : 1, switched = 0;
            for (;;) {
                int it = 0; if (l_ == 0) it = __hip_atomic_fetch_add(wq + mode, 1, __ATOMIC_RELAXED, __HIP_MEMORY_SCOPE_WORKGROUP);
                it = __builtin_amdgcn_readfirstlane(it);
                int ln = l_; asm volatile("" : "+v"(ln));
                GAS unsigned char* wi_g = (GAS unsigned char*)w; asm volatile("" : "+s"(wi_g)); unsigned char* const wi = (unsigned char*)wi_g;
                if (mode == 0) {
                    const int tile = grp * 8 + (it & 7) + (it >> 3) * nb8 * 8;
                    if (grp < nb8 && tile < T / 32) { route_tile((const bf16*)(wi + WS_PQ), (unsigned short*)(wi + WS_IDX), (float*)(wi + WS_GATE), ldsp, tile, ln, w_); continue; }
                } else {
                    constexpr int R = 4; const int wv = it & 7, rb = (int)blockIdx.x * NWAVES + wv + (it >> 4) * R * NGW_;
                    if (((it >> 3) & 1) == 0) { if (rb < 2 * NEXP) { quant_table_item(args.in, wi, l, rb, NGW_, ln); continue; } }
                    else if (rb < T) { int tt[R]; bool ok[R];
#pragma unroll
                        for (int u = 0; u < R; ++u) { tt[u] = rb + u * NGW_; ok[u] = tt[u] < T; if (!ok[u]) tt[u] = rb; }
                        quant_x_rows<R>((const bf16*)(wi + WS_X), (const float*)(wi + WS_SSQA), args.in[12] + (size_t)l * D, (unsigned char*)(wi + WS_XQ), (float*)(wi + WS_SX), tt, ok, ln); continue; }
                    else if (rb < 2 * NEXP) continue;
                }
                if (switched) break; switched = 1; mode ^= 1;
            } }
        SEAM(pb + 5);
        REPS(6) if ((SITES & 2048) && IN(pb + 6)) { FRESH_WS(w); FRESH_INT(l, L); FRESH_TID(t_, l_, w_);
            phase_upass((const unsigned char*)(w + WS_XQ), (const unsigned short*)(w + WS_IDX), (const unsigned char*)(w + WS_U8) + (size_t)l * 4 * NEXP * 128, (unsigned*)(w + WS_PA), l_, w_, G); }
        SEAM(pb + 6);
        REPS(7) if ((SITES & 2048) && IN(pb + 7)) { FRESH_WS(w); FRESH_INT(l, L); FRESH_TID(t_, l_, w_);
            phase_combine((const unsigned*)(w + WS_PA), (const unsigned short*)(w + WS_IDX), (const float*)(w + WS_GATE), (const float*)(w + WS_SX), (const unsigned*)(w + WS_SU) + (size_t)l * NEXP, ldsp,
                          (unsigned*)(w + WS_W), (float*)(w + WS_WSUM), l_, w_, G); }
        SEAM(pb + 7);
        if (PROBE_K == 8 && IN(pb + 8)) { FRESH_WS(w); FRESH_INT(l, L); FRESH_TID(t_, l_, w_);
            phase_vpass((bf16*)(w + WS_PQ), (const unsigned short*)(w + WS_IDX), (const unsigned*)(w + WS_W), (const float*)(w + WS_WSUM), (const unsigned char*)(w + WS_V8) + (size_t)l * 4 * NEXP * 128, (float*)(w + WS_SSQA), ldsp, l_, w_, G); __syncthreads(); }
        if ((SITES & 2048) && IN(pb + 8)) { FRESH_WS(w); FRESH_INT(l, L); FRESH_TID(t_, l_, w_);
            phase_vpass((bf16*)(w + WS_X), (const unsigned short*)(w + WS_IDX), (const unsigned*)(w + WS_W), (const float*)(w + WS_WSUM), (const unsigned char*)(w + WS_V8) + (size_t)l * 4 * NEXP * 128, (float*)(w + WS_SSQB), ldsp, l_, w_, G); }
        if (L < 3) { if (IN(pb + 8) && IN(pb + PH_PER_LAYER)) { ARRIVE(8); xcd_barrier(bar); SKEW(8); TICK(8); } }
        else {
            SEAM(pb + 8);
            if ((SITES & 2048) && IN(pb + 9)) { FRESH_WS(w); FRESH_TID(t_, l_, w_); phase_final_norm((const bf16*)(w + WS_X), (const float*)(w + WS_SSQB), args.in[17], args.out, l_, w_, G); }
#if SELFTEST
            if (IN(pb + 9)) { __syncthreads(); FRESH_TID(t_, l_, w_); if (__hip_atomic_load(ctl + CW_CODE, RLX_AGENT) != 0u && blockIdx.x == 0) { for (int i = t_; i < 4096; i += NWAVES * 64) args.out[i] = __builtin_nanf(""); } }
#endif
        }
    }
    if (PROBE_T != -99 && args.use_bar) {
        TICK(9);
        if (blockIdx.x == 0 && threadIdx.x == 0) { const unsigned long long t0_ = __builtin_amdgcn_s_memrealtime(); const unsigned long long hold_ = 4ull * tw_[0]; while (__builtin_amdgcn_s_memrealtime() - t0_ < hold_) __builtin_amdgcn_s_sleep(8); }
        xcd_barrier(bar);
    }
#undef IN
#undef SEAM
}

#ifndef ONE_LAUNCH
#define ONE_LAUNCH 1
#endif
static int g_grid = 0;
static void launch_phases(Args a, int lo, int hi, hipStream_t stream) {
    a.ph_lo = lo; a.ph_hi = hi; a.use_bar = (hi - lo > 1) ? 1 : 0;
    hipLaunchKernelGGL(mk_fwd, dim3(g_grid), dim3(NWAVES * 64), LDS_BYTES, stream, a);
}
extern "C" void kernel_launch(void* const* d_in, const int* in_sizes, int n_in, void* d_out, int out_size, void* d_ws, size_t ws_size, hipStream_t stream) {
    if (n_in != 18 || out_size != T * D || ws_size < WS_END) { fprintf(stderr, "kernel_launch: unexpected shapes (n_in %d out %d ws %zu)\n", n_in, out_size, ws_size); return; }
    if (g_grid == 0) {
        int dev = 0, cus = 0;
        if (hipGetDevice(&dev) != hipSuccess || hipDeviceGetAttribute(&cus, hipDeviceAttributeMultiprocessorCount, dev) != hipSuccess) { g_grid = -1; return; }
        if (hipFuncSetAttribute((const void*)mk_fwd, hipFuncAttributeMaxDynamicSharedMemorySize, LDS_BYTES) != hipSuccess) { fprintf(stderr, "kernel_launch: hipFuncSetAttribute failed\n"); g_grid = -1; return; }
        int per_cu = 0;
        if (hipOccupancyMaxActiveBlocksPerMultiprocessor(&per_cu, (const void*)mk_fwd, NWAVES * 64, LDS_BYTES) != hipSuccess || per_cu < 1) fprintf(stderr, "kernel_launch: occupancy query says %d\n", per_cu);
        (void)hipGetLastError();
        g_grid = cus;
    }
    if (g_grid < 0) return;
    (void)hipMemsetAsync((unsigned char*)d_ws + WS_CTL, 0, CTL_ZERO_BYTES, stream);
    Args a{}; for (int i = 0; i < 18; ++i) a.in[i] = (const float*)d_in[i]; a.out = (float*)d_out; a.ws = (unsigned char*)d_ws;
#if ONE_LAUNCH
    launch_phases(a, 0, PH_END, stream);
#else
    for (int p = 0; p < PH_END; ++p) launch_phases(a, p, p + 1, stream);
#endif
}
```
